# Optimizing an MI355X kernel written in HIP

```python
import math
import jax, jax.numpy as jnp
from jax import lax
import numpy as np

D_MODEL = 1024
BATCH = 4
SEQ = 4096
DEPTH = 2
DEC_BATCH = 8
DEC_SEQ = 4096
PAST_LEN = 128

FNET_GROUP_DIM = 64
FNET_GROUPS = 6
FNET_W = FNET_GROUPS * FNET_GROUP_DIM
S5_GROUP_DIM = 16
S5_GROUPS = 24
S5_W = S5_GROUPS * S5_GROUP_DIM
S5_STATE = 64
S5_DT_MIN = 0.001
S5_DT_MAX = 0.1
MLA_HEADS = 16
QK_NOPE = 64
QK_ROPE = 32
V_DIM = 64
Q_LORA = 384
KV_LORA = 256
ROPE_BASE = 10000.0
Q_BLOCK = 128
N_BRANCH = 3
D_FF = 4 * D_MODEL
EPS = 1e-6

OFF_FNET = 0
OFF_S5 = OFF_FNET + FNET_W
OFF_Q = OFF_S5 + S5_W
OFF_KV = OFF_Q + Q_LORA
OFF_KR = OFF_KV + KV_LORA
OFF_GATE = OFF_KR + QK_ROPE
IN_W = OFF_GATE + N_BRANCH * D_MODEL

kernel_name = "hybrid_fnet_s5_mla_encoder"


def rms_norm(x, g):
    x32 = x.astype(jnp.float32)
    y = x32 * lax.rsqrt(jnp.mean(x32 * x32, axis=-1, keepdims=True) + EPS)
    return (y * g.astype(jnp.float32)).astype(x.dtype)


def fourier_mix(u):
    b, l, _ = u.shape
    ug = u.astype(jnp.float32).reshape(b, l, FNET_GROUPS, FNET_GROUP_DIM)
    f = jnp.fft.fftn(ug, axes=(1, 3), norm="ortho")
    return jnp.real(f).reshape(b, l, FNET_W).astype(u.dtype)


def s5_scan(u, lam_re, lam_im, log_dt, b_re, b_im, c_re, c_im, reverse):
    f32 = jnp.float32
    lam = lax.complex(lam_re.astype(f32), lam_im.astype(f32))
    dt = jnp.exp(log_dt.astype(f32))[:, None]
    lam_bar = jnp.exp(lam * dt)
    b_bar = ((lam_bar - 1.0) / lam)[..., None] * lax.complex(b_re.astype(f32), b_im.astype(f32))
    bu = jnp.einsum('blgp,gnp->blgn', u.astype(jnp.complex64), b_bar)
    a = jnp.broadcast_to(lam_bar, bu.shape)

    def combine(e1, e2):
        a1, h1 = e1
        a2, h2 = e2
        return a1 * a2, a2 * h1 + h2

    _, h = lax.associative_scan(combine, (a, bu), axis=1, reverse=reverse)
    cmat = lax.complex(c_re.astype(f32), c_im.astype(f32))
    return jnp.real(jnp.einsum('blgn,gpn->blgp', h, cmat))


def s5_branch(u, lam_re, lam_im, log_dt, b_re, b_im, c_re, c_im, d_skip, w_glu):
    bsz, l, _ = u.shape
    u32 = u.astype(jnp.float32)
    ug = u32.reshape(bsz, l, S5_GROUPS, S5_GROUP_DIM)
    y_f = s5_scan(ug, lam_re[0], lam_im[0], log_dt[0], b_re[0], b_im[0], c_re[0], c_im[0], False)
    y_b = s5_scan(ug, lam_re[1], lam_im[1], log_dt[1], b_re[1], b_im[1], c_re[1], c_im[1], True)
    y = (y_f + y_b).reshape(bsz, l, S5_W) + d_skip.astype(jnp.float32) * u32
    y = jax.nn.gelu(y).astype(u.dtype)
    h = y @ w_glu
    return h[..., :S5_W] * jax.nn.sigmoid(h[..., S5_W:])


def apply_rope(x):
    l = x.shape[1]
    half = QK_ROPE // 2
    inv = ROPE_BASE ** (-jnp.arange(half, dtype=jnp.float32) / half)
    ang = jnp.arange(l, dtype=jnp.float32)[:, None] * inv[None, :]
    cos = jnp.cos(ang)[None, :, None, :]
    sin = jnp.sin(ang)[None, :, None, :]
    x32 = x.astype(jnp.float32)
    x1, x2 = x32[..., :half], x32[..., half:]
    return jnp.concatenate([x1 * cos - x2 * sin, x1 * sin + x2 * cos], axis=-1).astype(x.dtype)


def mla_branch(c_q, c_kv, k_rope, g_q, w_qb, g_kv, w_kvb, w_o):
    b, l, _ = c_q.shape
    q = (rms_norm(c_q, g_q) @ w_qb).reshape(b, l, MLA_HEADS, QK_NOPE + QK_ROPE)
    q = jnp.concatenate([q[..., :QK_NOPE], apply_rope(q[..., QK_NOPE:])], axis=-1)
    kv = (rms_norm(c_kv, g_kv) @ w_kvb).reshape(b, l, MLA_HEADS, QK_NOPE + V_DIM)
    k_pe = jnp.broadcast_to(apply_rope(k_rope[:, :, None, :]), (b, l, MLA_HEADS, QK_ROPE))
    k32 = jnp.concatenate([kv[..., :QK_NOPE], k_pe], axis=-1).astype(jnp.float32)
    v32 = kv[..., QK_NOPE:].astype(jnp.float32)
    scale = (QK_NOPE + QK_ROPE) ** -0.5
    q_blocks = q.reshape(b, l // Q_BLOCK, Q_BLOCK, MLA_HEADS, QK_NOPE + QK_ROPE).transpose(1, 0, 2, 3, 4)

    def attend(q_blk):
        s = jnp.einsum('bqhd,bkhd->bhqk', q_blk.astype(jnp.float32), k32) * scale
        p = jax.nn.softmax(s, axis=-1)
        return jnp.einsum('bhqk,bkhd->bqhd', p, v32)

    o = lax.map(attend, q_blocks)
    o = o.transpose(1, 0, 2, 3, 4).reshape(b, l, MLA_HEADS * V_DIM).astype(c_q.dtype)
    return o @ w_o


def encoder_layer(x, g_mix, w_in, w_fnet, s5_lam_re, s5_lam_im, s5_log_dt, s5_b_re, s5_b_im,
                  s5_c_re, s5_c_im, s5_d, w_glu, w_s5, g_q, w_qb, g_kv, w_kvb, w_o_mla,
                  w_out, g_mlp, w_up, w_down):
    b, l, _ = x.shape
    h = rms_norm(x, g_mix)
    z = h @ w_in
    y_a = fourier_mix(z[..., OFF_FNET:OFF_S5]) @ w_fnet
    y_b = s5_branch(z[..., OFF_S5:OFF_Q], s5_lam_re, s5_lam_im, s5_log_dt, s5_b_re, s5_b_im,
                    s5_c_re, s5_c_im, s5_d, w_glu) @ w_s5
    y_c = mla_branch(z[..., OFF_Q:OFF_KV], z[..., OFF_KV:OFF_KR], z[..., OFF_KR:OFF_GATE],
                     g_q, w_qb, g_kv, w_kvb, w_o_mla)
    gates = jax.nn.sigmoid(z[..., OFF_GATE:].astype(jnp.float32)).reshape(b, l, N_BRANCH, D_MODEL)
    merged = (gates[:, :, 0] * y_a.astype(jnp.float32)
              + gates[:, :, 1] * y_b.astype(jnp.float32)
              + gates[:, :, 2] * y_c.astype(jnp.float32)).astype(x.dtype)
    x = x + merged @ w_out
    h = rms_norm(x, g_mlp)
    x = x + jnp.square(jax.nn.relu(h @ w_up)) @ w_down
    return x


def trunk(x, g_mix, w_in, w_fnet, s5_lam_re, s5_lam_im, s5_log_dt, s5_b_re, s5_b_im,
          s5_c_re, s5_c_im, s5_d, w_glu, w_s5, g_q, w_qb, g_kv, w_kvb, w_o_mla,
          w_out, g_mlp, w_up, w_down, g_final):
    for i in range(DEPTH):
        x = encoder_layer(x, g_mix[i], w_in[i], w_fnet[i], s5_lam_re[i], s5_lam_im[i], s5_log_dt[i],
                          s5_b_re[i], s5_b_im[i], s5_c_re[i], s5_c_im[i], s5_d[i], w_glu[i], w_s5[i],
                          g_q[i], w_qb[i], g_kv[i], w_kvb[i], w_o_mla[i], w_out[i], g_mlp[i],
                          w_up[i], w_down[i])
    return rms_norm(x, g_final)


def setup_inputs(seed: int = 0) -> dict:
    key = jax.random.key(seed)
    ks = jax.random.split(key, 32)
    f32 = jnp.float32

    def nrm(k, shape, scale):
        return jax.random.normal(k, shape, f32) * scale

    def gain(k, shape):
        return 1.0 + 0.02 * jax.random.normal(k, shape, f32)

    G, N, P = S5_GROUPS, S5_STATE, S5_GROUP_DIM
    n_idx = jnp.arange(N, dtype=f32)
    inp = {
        "x_prompt": nrm(ks[0], (BATCH, SEQ, D_MODEL), 1.0),
        "x_sample": nrm(ks[1], (DEC_BATCH, DEC_SEQ, D_MODEL), 1.0),
        "g_mix": gain(ks[2], (DEPTH, D_MODEL)),
        "w_in": nrm(ks[3], (DEPTH, D_MODEL, IN_W), D_MODEL ** -0.5),
        "w_fnet": nrm(ks[4], (DEPTH, FNET_W, D_MODEL), FNET_W ** -0.5),
        "s5_lam_re": -0.5 + 0.01 * jax.random.normal(ks[5], (DEPTH, 2, G, N), f32),
        "s5_lam_im": math.pi * n_idx + 0.01 * jax.random.normal(ks[6], (DEPTH, 2, G, N), f32),
        "s5_log_dt": jax.random.uniform(ks[7], (DEPTH, 2, G), f32, math.log(S5_DT_MIN), math.log(S5_DT_MAX)),
        "s5_b_re": nrm(ks[8], (DEPTH, 2, G, N, P), (2.0 * P) ** -0.5),
        "s5_b_im": nrm(ks[9], (DEPTH, 2, G, N, P), (2.0 * P) ** -0.5),
        "s5_c_re": nrm(ks[10], (DEPTH, 2, G, P, N), (2.0 * N) ** -0.5),
        "s5_c_im": nrm(ks[11], (DEPTH, 2, G, P, N), (2.0 * N) ** -0.5),
        "s5_d": nrm(ks[12], (DEPTH, S5_W), 1.0),
        "w_glu": nrm(ks[13], (DEPTH, S5_W, 2 * S5_W), S5_W ** -0.5),
        "w_s5": nrm(ks[14], (DEPTH, S5_W, D_MODEL), S5_W ** -0.5),
        "g_q": gain(ks[15], (DEPTH, Q_LORA)),
        "w_qb": nrm(ks[16], (DEPTH, Q_LORA, MLA_HEADS * (QK_NOPE + QK_ROPE)), Q_LORA ** -0.5),
        "g_kv": gain(ks[17], (DEPTH, KV_LORA)),
        "w_kvb": nrm(ks[18], (DEPTH, KV_LORA, MLA_HEADS * (QK_NOPE + V_DIM)), KV_LORA ** -0.5),
        "w_o_mla": nrm(ks[19], (DEPTH, MLA_HEADS * V_DIM, D_MODEL), (MLA_HEADS * V_DIM) ** -0.5),
        "w_out": nrm(ks[20], (DEPTH, D_MODEL, D_MODEL), D_MODEL ** -0.5),
        "g_mlp": gain(ks[21], (DEPTH, D_MODEL)),
        "w_up": nrm(ks[22], (DEPTH, D_MODEL, D_FF), D_MODEL ** -0.5),
        "w_down": nrm(ks[23], (DEPTH, D_FF, D_MODEL), D_FF ** -0.5),
        "g_final": gain(ks[24], (D_MODEL,)),
    }
    return inp


def reference(x_prompt, x_sample, g_mix, w_in, w_fnet, s5_lam_re, s5_lam_im, s5_log_dt, s5_b_re,
              s5_b_im, s5_c_re, s5_c_im, s5_d, w_glu, w_s5, g_q, w_qb, g_kv, w_kvb, w_o_mla,
              w_out, g_mlp, w_up, w_down, g_final):
    params = (g_mix, w_in, w_fnet, s5_lam_re, s5_lam_im, s5_log_dt, s5_b_re, s5_b_im, s5_c_re,
              s5_c_im, s5_d, w_glu, w_s5, g_q, w_qb, g_kv, w_kvb, w_o_mla, w_out, g_mlp,
              w_up, w_down, g_final)
    y_prompt = trunk(x_prompt, *params)
    y_sample = trunk(x_sample, *params)
    return (y_prompt, y_sample)
```

```cpp
#include <hip/hip_runtime.h>
#include <hip/hip_cooperative_groups.h>
#include <cstdio>
#include <cstdint>
namespace cg = cooperative_groups;

#define DI __device__ __forceinline__
#define LAS __attribute__((address_space(3)))
typedef unsigned short bf16_t;
typedef short bf16x8 __attribute__((ext_vector_type(8)));
typedef short s16x4 __attribute__((ext_vector_type(4)));
typedef float f32x4 __attribute__((ext_vector_type(4)));
typedef float f32x16 __attribute__((ext_vector_type(16)));
typedef unsigned u32x4 __attribute__((ext_vector_type(4)));
typedef unsigned u32x2 __attribute__((ext_vector_type(2)));

constexpr int D = 1024, SEQ = 4096, NSEQ = 12, MTOT = NSEQ * SEQ, DEPTH = 2;
constexpr int CSEQ = 4, MC = CSEQ * SEQ, NCHUNK = NSEQ / CSEQ;
constexpr int FW = 384, S5W = 384, QL = 384, KVL = 256, NH = 16, DQK = 96, DV = 64, DFF = 4096;
constexpr int IN_W = 4512, INP = 4608;
constexpr int S5G = 24, S5P = 16, S5N = 64, TCH = 32, NCH = SEQ / TCH;
constexpr int U2LD = TCH * S5P + 256;
constexpr int DFTR = 2304, DFTM = 2 * DFTR;
constexpr float EPS = 1e-6f;
constexpr float QSCALE = 0.10206207261596577f * 1.4426950408889634f;

constexpr size_t MiB = 1u << 20;
constexpr size_t WS_ROPE = 0, WS_KTAB = MiB / 2;
constexpr size_t WS_W = 2 * MiB;
constexpr size_t W_IN = 0, W_F = W_IN + (size_t)INP * 1024 * 2, W_GLU = W_F + 1024 * 768 * 2, W_S5 = W_GLU + 768 * 384 * 2,
                 W_QB = W_S5 + 1024 * 384 * 2, W_KV = W_QB + 1536 * 384 * 2, W_O = W_KV + 2048 * 256 * 2, W_OUT = W_O + 1024 * 1024 * 2,
                 W_UP = W_OUT + 1024 * 1024 * 2, W_DOWN = W_UP + (size_t)4096 * 1024 * 2, W_END = W_DOWN + (size_t)4096 * 1024 * 2;
static_assert(W_END <= 34 * MiB, "weights");
constexpr size_t WS_DFT = 36 * MiB, WS_BT1 = 72 * MiB, WS_BT2 = 78 * MiB;
constexpr size_t WS_XB = 96 * MiB  , WS_ZT = 128 * MiB, WS_U2 = 140 * MiB, WS_S = 158 * MiB, WS_CQ = 170 * MiB, WS_CKV = 182 * MiB,
                 WS_KPE = 190 * MiB, WS_RSS = 191 * MiB  , WS_GATE = 192 * MiB, WS_HID = 288 * MiB  , WS_PQ = 288 * MiB, WS_YS5 = 312 * MiB, WS_GLU = 324 * MiB,
                 WS_Q = 336 * MiB, WS_KN = 384 * MiB, WS_VT = 416 * MiB, WS_MRG = 448 * MiB, WS_BAR = 480 * MiB, WS_END = 480 * MiB + 16384;

struct Params {
    const float* in[25];
    float* out;
    unsigned char* ws;
};
enum { I_XP = 0, I_XS, I_GMIX, I_WIN, I_WFNET, I_LRE, I_LIM, I_LDT, I_BRE, I_BIM, I_CRE, I_CIM, I_SD, I_WGLU, I_WS5, I_GQ, I_WQB, I_GKV, I_WKVB,
       I_WO, I_WOUT, I_GMLP, I_WUP, I_WDOWN, I_GFIN };

DI int opq0() { int z = 0; asm volatile("" : "+s"(z)); return z; }
DI int opqv(int x) { asm volatile("" : "+v"(x)); return x; }
DI int tid_opq() { int t = threadIdx.x; asm volatile("" : "+v"(t)); return t; }
typedef __bf16 bf16x2_t __attribute__((ext_vector_type(2)));
typedef float f32x2_t __attribute__((ext_vector_type(2)));
DI unsigned pk2(float lo, float hi) { const f32x2_t v = {lo, hi}; return __builtin_bit_cast(unsigned, __builtin_convertvector(v, bf16x2_t)); }
DI unsigned f2bf(float f) { return pk2(f, 0.f) & 0xffffu; }
DI float bf2f(unsigned h) { return __builtin_bit_cast(float, h << 16); }
DI float bflo(unsigned w) { return __builtin_bit_cast(float, w << 16); }
DI float bfhi(unsigned w) { return __builtin_bit_cast(float, w & 0xffff0000u); }
DI float sigmoidf_(float v) { return __builtin_amdgcn_rcpf(1.0f + __builtin_amdgcn_exp2f(v * -1.4426950408889634f)); }
DI float gelu_tanh(float x) { const float u2 = 1.5957691216057308f * (x + 0.044715f * x * x * x); return x * sigmoidf_(u2); }

namespace pg8 {
constexpr int BM = 256, BK = 64, HALF = 128, HTB = HALF * BK * 2, STAGE_BYTES = 8 * HTB, NXCD = 8, WGM = 8;
DI int lds_byte(int r, int c) { const int st = (r >> 4) * 2 + (c >> 5), rr = r & 15, cc = c & 31, ob = rr * 64 + cc * 2; return st * 1024 + (ob ^ (((ob >> 9) & 1) << 5)); }
DI void stage_rc(int b, int& R, int& C) { const int st = b / 1024, sb = b % 1024, swz = sb ^ (((sb >> 9) & 1) << 5); R = (st >> 1) * 16 + swz / 64; C = (st & 1) * 32 + (swz % 64) / 2; }
DI int perm32(int rho) { const int n = rho >> 4, i = rho & 15; return 8 * (i >> 2) + 4 * n + (i & 3); }

struct Unit { int pm, pn, z; };
struct Gemm { const bf16_t* A; const bf16_t* Bt; int lda, ldb, K; size_t sA, sB; };

struct Sched {
    int nM, nN, per, nwg, G, c, base;
    DI void init(int nM_, int nN_, int nB_, int G_, int blk, int off) { nM = nM_; nN = nN_; per = nM * nN; nwg = per * nB_; G = G_; c = (blk + G_ - (off % G_)) % G_; base = 0; }
    DI bool next(int i, Unit& u) const {
        const long L = (long)base + (long)i * G + c; if (L >= nwg) return false;
        const int z = (int)(L / per); int wgid = (int)(L % per);
        if (per >= 64) { const int q = per / NXCD, r = per % NXCD, xcd = wgid % NXCD, off = wgid / NXCD; wgid = (xcd < r ? xcd * (q + 1) : r * (q + 1) + (xcd - r) * q) + off; }
        const int nig = WGM * nN, gid = wgid / nig, fm = gid * WGM, gsz = (nM - fm) < WGM ? (nM - fm) : WGM;
        u.pm = fm + ((wgid % nig) % gsz); u.pn = (wgid % nig) / gsz; u.z = z; return true;
    }
};

template <class Epi>
DI void gemm_phase(LAS unsigned char* lds, const Gemm g, const Sched& S, const Epi& E) {
    const int tid = tid_opq(), wid = __builtin_amdgcn_readfirstlane(tid >> 6), lane = tid & 63, wr = wid >> 2, wc = wid & 3, fr = lane & 15, fq = lane >> 4;
    const int K = g.K, nt = K / BK;
    unsigned voffA[2], voffB[2];
#pragma unroll
    for (int i = 0; i < 2; ++i) { int R, C; stage_rc(tid * 16 + i * 8192, R, C); const int Rb = (R & ~31) + perm32(R & 31);
        voffA[i] = (unsigned)(R * g.lda + C) * 2u; voffB[i] = (unsigned)(Rb * g.ldb + C) * 2u; }
    const size_t kstep = (size_t)(BK * 2);
    const size_t hstepA = (size_t)HALF * g.lda * 2, hstepB = (size_t)HALF * g.ldb * 2;
    const size_t tstepA = 2 * hstepA, tstepB = 2 * hstepB;
    const unsigned ldsw = (unsigned)wid * 1024u;
    const int aoff = lds_byte(wr * 64 + fr, fq * 8), boff = lds_byte(wc * 32 + fr, fq * 8);
#define PG8_SA(b, h) (((b) * 2 + (h)) * HTB)
#define PG8_SB(b, h) ((4 + (b) * 2 + (h)) * HTB)
#define PG8_STAGE(bufoff, gbase, voff) do { _Pragma("unroll") for (int _i = 0; _i < 2; ++_i) \
        __builtin_amdgcn_global_load_lds((const unsigned*)((const char*)(gbase) + (voff)[_i]), (LAS unsigned*)(lds + (bufoff) + ldsw + _i * 8192), 16, 0, 0); } while (0)
#define PG8_LDA(dst, b, h) do { _Pragma("unroll") for (int m = 0; m < 4; ++m) _Pragma("unroll") for (int k = 0; k < 2; ++k) dst[m][k] = *(const LAS bf16x8*)(lds + PG8_SA(b, h) + aoff + m * 2048 + k * 1024); } while (0)
#define PG8_LDB(dst, b, h) do { _Pragma("unroll") for (int n = 0; n < 2; ++n) _Pragma("unroll") for (int k = 0; k < 2; ++k) dst[n][k] = *(const LAS bf16x8*)(lds + PG8_SB(b, h) + boff + n * 2048 + k * 1024); } while (0)
#define PG8_MMA(ai, bj, At, Bt) do { __builtin_amdgcn_s_setprio(1); _Pragma("unroll") for (int m = 0; m < 4; ++m) _Pragma("unroll") for (int n = 0; n < 2; ++n) _Pragma("unroll") for (int k = 0; k < 2; ++k) \
        acc[ai][bj][m][n] = __builtin_amdgcn_mfma_f32_16x16x32_bf16(Bt[n][k], At[m][k], acc[ai][bj][m][n], 0, 0, 0); __builtin_amdgcn_s_setprio(0); } while (0)
#define PG8_WAIT_V(n) asm volatile("s_waitcnt vmcnt(" #n ")" ::: "memory")
#define PG8_WAIT_L(n) asm volatile("s_waitcnt lgkmcnt(" #n ")" ::: "memory")
#define PG8_BAR __builtin_amdgcn_s_barrier()
#define PG8_SCHED __builtin_amdgcn_sched_barrier(0)
    Unit cur, nxt; int ui = 0;
    if (!S.next(0, cur)) return;
    f32x4 acc[2][2][4][2];
#pragma unroll
    for (int a = 0; a < 2; ++a)
#pragma unroll
        for (int b = 0; b < 2; ++b)
#pragma unroll
            for (int m = 0; m < 4; ++m)
#pragma unroll
                for (int n = 0; n < 2; ++n) acc[a][b][m][n] = (f32x4){0.f, 0.f, 0.f, 0.f};
    bf16x8 At[4][2], B0[2][2], B1[2][2];
    const char* cA = (const char*)g.A + (size_t)cur.z * g.sA * 2 + (size_t)cur.pm * tstepA;
    const char* cB = (const char*)g.Bt + (size_t)cur.z * g.sB * 2 + (size_t)cur.pn * tstepB;
    PG8_STAGE(PG8_SB(0, 0), cB, voffB); PG8_STAGE(PG8_SB(0, 1), cB + hstepB, voffB); PG8_STAGE(PG8_SA(0, 0), cA, voffA); PG8_STAGE(PG8_SA(0, 1), cA + hstepA, voffA);
    if (wr == 1) PG8_BAR;
    PG8_WAIT_V(2); PG8_BAR;
    PG8_STAGE(PG8_SB(1, 0), cB + kstep, voffB); PG8_STAGE(PG8_SA(1, 0), cA + kstep, voffA); PG8_STAGE(PG8_SB(1, 1), cB + hstepB + kstep, voffB);
    PG8_WAIT_V(6); PG8_BAR;
    for (;;) {
        const bool has_next = S.next(ui + 1, nxt);
        const char* nA = has_next ? (const char*)g.A + (size_t)nxt.z * g.sA * 2 + (size_t)nxt.pm * tstepA : cA;
        const char* nB = has_next ? (const char*)g.Bt + (size_t)nxt.z * g.sB * 2 + (size_t)nxt.pn * tstepB : cB;
#pragma clang loop unroll(disable)
        for (int t = 0; t < nt; t += 2) {
            const bool last = (t == nt - 2);
            const char* a1 = cA + (size_t)(t + 1) * kstep;
            const char* a2 = last ? nA : cA + (size_t)(t + 2) * kstep; const char* b2 = last ? nB : cB + (size_t)(t + 2) * kstep;
            const char* a3 = a2 + kstep; const char* b3 = b2 + kstep;
            PG8_LDB(B0, 0, 0); PG8_LDB(B1, 0, 1); PG8_SCHED; PG8_LDA(At, 0, 0); PG8_STAGE(PG8_SA(1, 1), a1 + hstepA, voffA);
            PG8_WAIT_V(8); PG8_WAIT_L(0); PG8_BAR; PG8_MMA(0, 0, At, B0); PG8_MMA(0, 1, At, B1); PG8_BAR; PG8_SCHED;
            PG8_LDA(At, 0, 1); PG8_STAGE(PG8_SB(0, 0), b2, voffB); PG8_STAGE(PG8_SB(0, 1), b2 + hstepB, voffB); PG8_STAGE(PG8_SA(0, 0), a2, voffA);
            PG8_WAIT_V(8); PG8_WAIT_L(0); PG8_BAR; PG8_MMA(1, 0, At, B0); PG8_MMA(1, 1, At, B1); PG8_BAR; PG8_SCHED;
            PG8_LDB(B0, 1, 0); PG8_LDB(B1, 1, 1); PG8_SCHED; PG8_LDA(At, 1, 0); PG8_STAGE(PG8_SA(0, 1), a2 + hstepA, voffA);
            PG8_WAIT_V(8); PG8_WAIT_L(0); PG8_BAR; PG8_MMA(0, 0, At, B0); PG8_MMA(0, 1, At, B1); PG8_BAR; PG8_SCHED;
            PG8_LDA(At, 1, 1); PG8_STAGE(PG8_SB(1, 0), b3, voffB); PG8_STAGE(PG8_SB(1, 1), b3 + hstepB, voffB); PG8_STAGE(PG8_SA(1, 0), a3, voffA);
            PG8_WAIT_V(8); PG8_WAIT_L(0); PG8_BAR; PG8_MMA(1, 0, At, B0); PG8_MMA(1, 1, At, B1); PG8_BAR; PG8_SCHED;
        }
        if (wr == 0) PG8_BAR;
        { int fr2 = fr, fq2 = fq; asm volatile("" : "+v"(fr2), "+v"(fq2)); E(acc, cur, wr, wc, fr2, fq2); }
        if (!has_next) break;
#pragma unroll
        for (int a = 0; a < 2; ++a)
#pragma unroll
            for (int b = 0; b < 2; ++b)
#pragma unroll
                for (int m = 0; m < 4; ++m)
#pragma unroll
                    for (int n = 0; n < 2; ++n) acc[a][b][m][n] = (f32x4){0.f, 0.f, 0.f, 0.f};
        cur = nxt; cA = nA; cB = nB; ++ui;
        if (wr == 1) PG8_BAR;
    }
    PG8_WAIT_V(0);
    PG8_BAR;
#undef PG8_SA
#undef PG8_SB
#undef PG8_STAGE
#undef PG8_LDA
#undef PG8_LDB
#undef PG8_MMA
#undef PG8_WAIT_V
#undef PG8_WAIT_L
#undef PG8_BAR
#undef PG8_SCHED
}
}
using pg8::Unit; using pg8::Gemm; using pg8::Sched;
typedef f32x4 Acc[2][2][4][2];

#define EPI_FOR(u) \
    _Pragma("unroll") for (int ai = 0; ai < 2; ++ai) _Pragma("unroll") for (int m = 0; m < 4; ++m) _Pragma("unroll") for (int bj = 0; bj < 2; ++bj)
#define EPI_ROW(u) ((u).pm * 256 + ai * 128 + wr * 64 + m * 16 + fr)
#define EPI_CB(u) ((u).pn * 256 + bj * 128 + wc * 32)
#define EPI_COL(u) (EPI_CB(u) + 8 * fq)
#define EPI_V(v) float v[8] = {acc[ai][bj][m][0][0], acc[ai][bj][m][0][1], acc[ai][bj][m][0][2], acc[ai][bj][m][0][3], acc[ai][bj][m][1][0], acc[ai][bj][m][1][1], acc[ai][bj][m][1][2], acc[ai][bj][m][1][3]}
DI u32x4 pack8(const float* v) { u32x4 w; w.x = pk2(v[0], v[1]); w.y = pk2(v[2], v[3]); w.z = pk2(v[4], v[5]); w.w = pk2(v[6], v[7]); return w; }

struct EpiIn {
    bf16_t *cq, *ckv, *kpe, *u2, *zt, *gate; const float2* rope;
    DI void operator()(const Acc& acc, const Unit& u, int wr, int wc, int fr, int fq) const {
        const int K384 = opqv(384), K1152 = opqv(1152);
        EPI_FOR(u) {
            const int row = EPI_ROW(u), cb = EPI_CB(u), col = cb + 8 * fq; EPI_V(v);
            const int bl = row >> 12, pos = row & 4095;
            if (cb >= 1536) {
#pragma unroll
                for (int j = 0; j < 8; ++j) v[j] = sigmoidf_(v[j]);
                *(u32x4*)(gate + (size_t)row * 3072 + (col - 1536)) = pack8(v);
            } else if (cb < 384) {
                *(u32x4*)(cq + (size_t)row * 384 + col) = pack8(v);
            } else if (cb < 640) {
                *(u32x4*)(ckv + (size_t)row * 256 + (col - 384)) = pack8(v);
            } else if (cb < 672) {
                const int i0 = (col - 640) >> 1; float o[8];
#pragma unroll
                for (int j = 0; j < 4; ++j) { const float2 cs = rope[pos * 16 + i0 + j]; o[2 * j] = v[2 * j] * cs.x - v[2 * j + 1] * cs.y; o[2 * j + 1] = v[2 * j] * cs.y + v[2 * j + 1] * cs.x; }
                *(u32x4*)(kpe + (size_t)row * 32 + (col - 640)) = pack8(o);
            } else if (cb < 768) {
            } else if (cb < 1152) {
                const int ch = col - 768, g = ch >> 4, q0 = ch & 15, c = pos >> 5, t = pos & 31;
                *(u32x4*)(u2 + ((size_t)g * 512 + bl * 128 + c) * U2LD + t * 16 + q0) = pack8(v);
            } else {
                const int ch = col - K1152;
#pragma unroll
                for (int j = 0; j < 8; ++j) zt[((size_t)(bl * K384 + ch + j)) * 4096 + pos] = (bf16_t)f2bf(v[j]);
            }
        }
    }
};
struct EpiDft {
    bf16_t* pq;
    DI void operator()(const Acc& acc, const Unit& u, int wr, int wc, int fr, int fq) const {
        const int K384 = opqv(384), K2304 = opqv(DFTR);
        EPI_FOR(u) {
            const int row = EPI_ROW(u), col = EPI_COL(u); EPI_V(v);
            const int type = row >= DFTR, k = row - type * K2304, bl = col / 384, ch = col - bl * K384;
            if (k <= 2048) {
                *(u32x4*)(pq + ((size_t)bl * 4096 + k) * 768 + type * K384 + ch) = pack8(v);
                if (k >= 1 && k <= 2047) {
                    if (type) {
#pragma unroll
                        for (int j = 0; j < 8; ++j) v[j] = -v[j];
                    }
                    *(u32x4*)(pq + ((size_t)bl * 4096 + (4096 - k)) * 768 + type * K384 + ch) = pack8(v);
                }
            }
        }
    }
};
struct EpiS1 {
    float* s;
    DI void operator()(const Acc& acc, const Unit& u, int wr, int wc, int fr, int fq) const {
        EPI_FOR(u) {
            const int row = EPI_ROW(u), col = EPI_COL(u);
            float* p = s + ((size_t)u.z * 512 + row) * 256 + col;
            *(f32x4*)p = acc[ai][bj][m][0]; *(f32x4*)(p + 4) = acc[ai][bj][m][1];
        }
    }
};
struct EpiS2 {
    const bf16_t* u2; const float* dsk; bf16_t* ys;
    DI void operator()(const Acc& acc, const Unit& u, int wr, int wc, int fr, int fq) const {
        EPI_FOR(u) {
            const int row = EPI_ROW(u), col = EPI_COL(u); EPI_V(v);
            const int t = col >> 4, p0 = col & 15, g = u.z;
            const u32x4 uu = *(const u32x4*)(u2 + ((size_t)g * 512 + row) * U2LD + col);
            const float uf[8] = {bflo(uu.x), bfhi(uu.x), bflo(uu.y), bfhi(uu.y), bflo(uu.z), bfhi(uu.z), bflo(uu.w), bfhi(uu.w)};
#pragma unroll
            for (int j = 0; j < 8; ++j) v[j] = gelu_tanh(v[j] + dsk[g * 16 + p0 + j] * uf[j]);
            *(u32x4*)(ys + ((size_t)row * 32 + t) * 384 + g * 16 + p0) = pack8(v);
        }
    }
};
struct EpiMerge {
    const bf16_t* gate; bf16_t* mrg; int gi; int accum;
    DI void operator()(const Acc& acc, const Unit& u, int wr, int wc, int fr, int fq) const {
        EPI_FOR(u) {
            const int row = EPI_ROW(u), col = EPI_COL(u); EPI_V(v);
            const u32x4 gg = *(const u32x4*)(gate + (size_t)row * 3072 + gi * 1024 + col);
            const float gf[8] = {bflo(gg.x), bfhi(gg.x), bflo(gg.y), bfhi(gg.y), bflo(gg.z), bfhi(gg.z), bflo(gg.w), bfhi(gg.w)};
            bf16_t* mp = mrg + (size_t)row * 1024 + col;
            if (accum) {
                const u32x4 oo = *(const u32x4*)mp;
                const float of[8] = {bflo(oo.x), bfhi(oo.x), bflo(oo.y), bfhi(oo.y), bflo(oo.z), bfhi(oo.z), bflo(oo.w), bfhi(oo.w)};
#pragma unroll
                for (int j = 0; j < 8; ++j) v[j] = of[j] + gf[j] * v[j];
            } else {
#pragma unroll
                for (int j = 0; j < 8; ++j) v[j] = gf[j] * v[j];
            }
            *(u32x4*)mp = pack8(v);
        }
    }
};
struct EpiQ {
    bf16_t* q; const float2* rope;
    DI void operator()(const Acc& acc, const Unit& u, int wr, int wc, int fr, int fq) const {
        EPI_FOR(u) {
            const int row = EPI_ROW(u), col = EPI_COL(u); EPI_V(v);
            const int pos = row & 4095, d = col % 96;
            if ((EPI_CB(u) % 96) >= 64) {
                const int i0 = (d - 64) >> 1; float o[8];
#pragma unroll
                for (int j = 0; j < 4; ++j) { const float2 cs = rope[pos * 16 + i0 + j]; o[2 * j] = v[2 * j] * cs.x - v[2 * j + 1] * cs.y; o[2 * j + 1] = v[2 * j] * cs.y + v[2 * j + 1] * cs.x; }
#pragma unroll
                for (int j = 0; j < 8; ++j) v[j] = o[j];
            }
#pragma unroll
            for (int j = 0; j < 8; ++j) v[j] *= QSCALE;
            *(u32x4*)(q + (size_t)row * 1536 + col) = pack8(v);
        }
    }
};
struct EpiKV {
    bf16_t *kn, *vt;
    DI void operator()(const Acc& acc, const Unit& u, int wr, int wc, int fr, int fq) const {
        EPI_FOR(u) {
            const int row = EPI_ROW(u), col = EPI_COL(u); EPI_V(v);
            const int bl = row >> 12, pos = row & 4095;
            if (EPI_CB(u) < 1024) {
                const int h = col >> 6, d0 = col & 63;
                *(u32x4*)(kn + (((size_t)(bl * 16 + h)) * 4096 + pos) * 64 + d0) = pack8(v);
            } else {
                const int c2 = col - 1024, h = c2 >> 6, d0 = c2 & 63;
#pragma unroll
                for (int j = 0; j < 8; ++j) vt[(((size_t)(bl * 16 + h)) * 64 + d0 + j) * 4096 + pos] = (bf16_t)f2bf(v[j]);
            }
        }
    }
};
struct EpiGlu {
    bf16_t* o;
    DI void operator()(const Acc& acc, const Unit& u, int wr, int wc, int fr, int fq) const {
        EPI_FOR(u) {
            const int row = EPI_ROW(u), col = EPI_COL(u); EPI_V(v);
            u32x2 w; w.x = pk2(v[0] * sigmoidf_(v[1]), v[2] * sigmoidf_(v[3])); w.y = pk2(v[4] * sigmoidf_(v[5]), v[6] * sigmoidf_(v[7]));
            *(u32x2*)(o + (size_t)row * 384 + (col >> 1)) = w;
        }
    }
};
struct EpiRes {
    const float* res; float* out;
    DI void operator()(const Acc& acc, const Unit& u, int wr, int wc, int fr, int fq) const {
        EPI_FOR(u) {
            const int row = EPI_ROW(u), col = EPI_COL(u);
            const float* rp = res + (size_t)row * 1024 + col; float* op = out + (size_t)row * 1024 + col;
            const f32x4 r0 = *(const f32x4*)rp, r1 = *(const f32x4*)(rp + 4);
            *(f32x4*)op = r0 + acc[ai][bj][m][0]; *(f32x4*)(op + 4) = r1 + acc[ai][bj][m][1];
        }
    }
};
struct EpiUp {
    bf16_t* h;
    DI void operator()(const Acc& acc, const Unit& u, int wr, int wc, int fr, int fq) const {
        EPI_FOR(u) {
            const int row = EPI_ROW(u), col = EPI_COL(u); EPI_V(v);
#pragma unroll
            for (int j = 0; j < 8; ++j) { const float r = v[j] > 0.f ? v[j] : 0.f; v[j] = r * r; }
            *(u32x4*)(h + (size_t)row * 4096 + col) = pack8(v);
        }
    }
};

struct EpiResN {
    const float* res; float* out; bf16_t* xb; float* rss;
    DI void operator()(const Acc& acc, const Unit& u, int wr, int wc, int fr, int fq) const {
#pragma unroll
        for (int ai = 0; ai < 2; ++ai)
#pragma unroll
            for (int m = 0; m < 4; ++m) {
                const int row = EPI_ROW(u); float part = 0.f;
#pragma unroll
                for (int bj = 0; bj < 2; ++bj) {
                    const int col = EPI_COL(u);
                    const float* rp = res + (size_t)row * 1024 + col; float* op = out + (size_t)row * 1024 + col;
                    const f32x4 o0 = *(const f32x4*)rp + acc[ai][bj][m][0], o1 = *(const f32x4*)(rp + 4) + acc[ai][bj][m][1];
                    *(f32x4*)op = o0; *(f32x4*)(op + 4) = o1;
                    part += o0[0] * o0[0] + o0[1] * o0[1] + o0[2] * o0[2] + o0[3] * o0[3] + o1[0] * o1[0] + o1[1] * o1[1] + o1[2] * o1[2] + o1[3] * o1[3];
                    const float v[8] = {o0[0], o0[1], o0[2], o0[3], o1[0], o1[1], o1[2], o1[3]};
                    *(u32x4*)(xb + (size_t)row * 1024 + col) = pack8(v);
                }
                part += __shfl_xor(part, 16); part += __shfl_xor(part, 32);
                if (fq == 0) atomicAdd(rss + row, part);
            }
    }
};
struct EpiUpN {
    bf16_t* h; const float* rss;
    DI void operator()(const Acc& acc, const Unit& u, int wr, int wc, int fr, int fq) const {
#pragma unroll
        for (int ai = 0; ai < 2; ++ai)
#pragma unroll
            for (int m = 0; m < 4; ++m) {
                const int row = EPI_ROW(u); const float r2 = __builtin_amdgcn_rcpf(ldexpf(rss[row], -10) + EPS);
#pragma unroll
                for (int bj = 0; bj < 2; ++bj) {
                    const int col = EPI_COL(u); EPI_V(v);
#pragma unroll
                    for (int j = 0; j < 8; ++j) { const float r = v[j] > 0.f ? v[j] : 0.f; v[j] = r * r * r2; }
                    *(u32x4*)(h + (size_t)row * 4096 + col) = pack8(v);
                }
            }
    }
};

constexpr int KPITCH = 208, VPITCH = 136, KBUF = 64 * KPITCH, VBUF = 64 * VPITCH;
DI void attn_unit(LAS unsigned char* lds, const bf16_t* Q, const bf16_t* Kn, const bf16_t* Kpe, const bf16_t* Vt, bf16_t* O, int b, int h, int qb) {
    const int tid = tid_opq(), wid = __builtin_amdgcn_readfirstlane(tid >> 6), lane = tid & 63, r32 = lane & 31, hi = lane >> 5;
    LAS unsigned char* Ks = lds; LAS unsigned char* Vs = lds + 2 * KBUF;
    const int qrow = b * 4096 + qb * 512 + wid * 64 + r32;
    bf16x8 qf[2][6];
#pragma unroll
    for (int j = 0; j < 2; ++j)
#pragma unroll
        for (int s = 0; s < 6; ++s) qf[j][s] = *(const bf16x8*)(Q + (size_t)(qrow + 32 * j) * 1536 + h * 96 + 16 * s + 8 * hi);
    const bf16_t* kn_b = Kn + (size_t)(b * 16 + h) * 4096 * 64; const bf16_t* kp_b = Kpe + (size_t)b * 4096 * 32; const bf16_t* vt_b = Vt + (size_t)(b * 16 + h) * 64 * 4096;
    const unsigned kn_o = (unsigned)((tid >> 3) * 64 + (tid & 7) * 8), kp_o = (unsigned)((tid >> 2) * 32 + (tid & 3) * 8), vt_o = (unsigned)((tid >> 3) * 4096 + (tid & 7) * 8);
#define kn_g (kn_b + kn_o)
#define kp_g (kp_b + kp_o)
#define vt_g (vt_b + vt_o)
    const int kn_l = (tid >> 3) * KPITCH + (tid & 7) * 16, kp_l = (tid >> 2) * KPITCH + 128 + (tid & 3) * 16, vt_l = (tid >> 3) * VPITCH + (tid & 7) * 16;
    u32x4 rk = *(const u32x4*)kn_g, rp = (u32x4){0, 0, 0, 0}, rv = *(const u32x4*)vt_g;
    if (tid < 256) rp = *(const u32x4*)kp_g;
    f32x16 o[2][2];
#pragma unroll
    for (int j = 0; j < 2; ++j)
#pragma unroll
        for (int i = 0; i < 16; ++i) { o[j][0][i] = 0.f; o[j][1][i] = 0.f; }
    float mrun[2] = {0.f, 0.f}, lsum[2] = {0.f, 0.f};
    __syncthreads();
    *(LAS u32x4*)(Ks + kn_l) = rk; if (tid < 256) *(LAS u32x4*)(Ks + kp_l) = rp;
    *(LAS u32x2*)(Vs + vt_l) = (u32x2){rv.x, rv.y}; *(LAS u32x2*)(Vs + vt_l + 8) = (u32x2){rv.z, rv.w};
    __syncthreads();
    for (int kt = 0; kt < 64; ++kt) {
        const int buf = kt & 1;
        LAS unsigned char* kb = Ks + buf * KBUF; LAS unsigned char* vb = Vs + buf * VBUF;
        f32x16 s[2][2];
#pragma unroll
        for (int j = 0; j < 2; ++j) { const float negm = -mrun[j];
#pragma unroll
            for (int i = 0; i < 16; ++i) { s[j][0][i] = negm; s[j][1][i] = negm; } }
        if (wid < 4) __builtin_amdgcn_s_setprio(3); else __builtin_amdgcn_s_setprio(1);
#pragma unroll
        for (int t = 0; t < 6; ++t) {
            const bf16x8 ka0 = *(const LAS bf16x8*)(kb + r32 * KPITCH + (16 * t + 8 * hi) * 2);
            const bf16x8 ka1 = *(const LAS bf16x8*)(kb + (32 + r32) * KPITCH + (16 * t + 8 * hi) * 2);
#pragma unroll
            for (int j = 0; j < 2; ++j) {
                s[j][0] = __builtin_amdgcn_mfma_f32_32x32x16_bf16(ka0, qf[j][t], s[j][0], 0, 0, 0);
                s[j][1] = __builtin_amdgcn_mfma_f32_32x32x16_bf16(ka1, qf[j][t], s[j][1], 0, 0, 0);
            }
        }
        __builtin_amdgcn_s_setprio(0);
        __builtin_amdgcn_sched_barrier(0);
        if (kt + 1 < 64) {
            rk = *(const u32x4*)(kn_b + (kn_o + (unsigned)(kt + 1) * 4096u)); rv = *(const u32x4*)(vt_b + (vt_o + (unsigned)(kt + 1) * 64u));
            if (tid < 256) rp = *(const u32x4*)(kp_b + (kp_o + (unsigned)(kt + 1) * 2048u));
        }
        __builtin_amdgcn_sched_barrier(0);
        float mx[2];
#pragma unroll
        for (int j = 0; j < 2; ++j) {
            mx[j] = fmaxf(s[j][0][0], s[j][1][0]);
#pragma unroll
            for (int i = 1; i < 16; ++i) mx[j] = fmaxf(mx[j], fmaxf(s[j][0][i], s[j][1][i]));
        }
        { const float o0 = __shfl_xor(mx[0], 32), o1 = __shfl_xor(mx[1], 32); mx[0] = fmaxf(mx[0], o0); mx[1] = fmaxf(mx[1], o1); }
        if (kt == 0 || __builtin_amdgcn_ballot_w64(fmaxf(mx[0], mx[1]) > 6.0f) != 0ull) {
#pragma unroll
            for (int j = 0; j < 2; ++j) {
                const float dlt = kt == 0 ? mx[j] : fmaxf(mx[j], 0.f), alpha = __builtin_amdgcn_exp2f(-dlt);
                mrun[j] += dlt; lsum[j] *= alpha;
#pragma unroll
                for (int i = 0; i < 16; ++i) { s[j][0][i] -= dlt; s[j][1][i] -= dlt; o[j][0][i] *= alpha; o[j][1][i] *= alpha; }
            }
        }
#pragma unroll
        for (int j = 0; j < 2; ++j) {
            float ps = 0.f;
#pragma unroll
            for (int i = 0; i < 16; ++i) { s[j][0][i] = __builtin_amdgcn_exp2f(s[j][0][i]); s[j][1][i] = __builtin_amdgcn_exp2f(s[j][1][i]); ps += s[j][0][i] + s[j][1][i]; }
            lsum[j] += ps;
        }
        if (wid < 4) __builtin_amdgcn_s_setprio(3); else __builtin_amdgcn_s_setprio(1);
#pragma unroll
        for (int kbk = 0; kbk < 2; ++kbk) {
#pragma unroll
            for (int t = 0; t < 2; ++t) {
                const int koff = (32 * kbk + 16 * t + 4 * hi) * 2;
                const s16x4 a0l = *(const LAS s16x4*)(vb + r32 * VPITCH + koff), a0h = *(const LAS s16x4*)(vb + r32 * VPITCH + koff + 16);
                const s16x4 a1l = *(const LAS s16x4*)(vb + (32 + r32) * VPITCH + koff), a1h = *(const LAS s16x4*)(vb + (32 + r32) * VPITCH + koff + 16);
                const bf16x8 va0 = __builtin_shufflevector(a0l, a0h, 0, 1, 2, 3, 4, 5, 6, 7), va1 = __builtin_shufflevector(a1l, a1h, 0, 1, 2, 3, 4, 5, 6, 7);
#pragma unroll
                for (int j = 0; j < 2; ++j) {
                    u32x4 pw;
                    pw.x = pk2(s[j][kbk][8 * t], s[j][kbk][8 * t + 1]); pw.y = pk2(s[j][kbk][8 * t + 2], s[j][kbk][8 * t + 3]);
                    pw.z = pk2(s[j][kbk][8 * t + 4], s[j][kbk][8 * t + 5]); pw.w = pk2(s[j][kbk][8 * t + 6], s[j][kbk][8 * t + 7]);
                    const bf16x8 pb = __builtin_bit_cast(bf16x8, pw);
                    o[j][0] = __builtin_amdgcn_mfma_f32_32x32x16_bf16(va0, pb, o[j][0], 0, 0, 0);
                    o[j][1] = __builtin_amdgcn_mfma_f32_32x32x16_bf16(va1, pb, o[j][1], 0, 0, 0);
                }
            }
        }
        __builtin_amdgcn_s_setprio(0);
        if (kt + 1 < 64) {
            LAS unsigned char* kn2 = Ks + (buf ^ 1) * KBUF; LAS unsigned char* vn2 = Vs + (buf ^ 1) * VBUF;
            *(LAS u32x4*)(kn2 + kn_l) = rk; if (tid < 256) *(LAS u32x4*)(kn2 + kp_l) = rp;
            *(LAS u32x2*)(vn2 + vt_l) = (u32x2){rv.x, rv.y}; *(LAS u32x2*)(vn2 + vt_l + 8) = (u32x2){rv.z, rv.w};
        }
        __syncthreads();
    }
    const int tid2 = tid_opq(), lane2 = tid2 & 63, hi2 = lane2 >> 5;
    const int qrow2 = b * 4096 + qb * 512 + __builtin_amdgcn_readfirstlane(tid2 >> 6) * 64 + (lane2 & 31);
#pragma unroll
    for (int j = 0; j < 2; ++j) {
        const float l = lsum[j] + __shfl_xor(lsum[j], 32), inv = 1.0f / l;
        bf16_t* op = O + (size_t)(qrow2 + 32 * j) * 1024 + h * 64;
#pragma unroll
        for (int g4 = 0; g4 < 4; ++g4) {
            u32x2 w0, w1;
            w0.x = pk2(o[j][0][4 * g4] * inv, o[j][0][4 * g4 + 1] * inv); w0.y = pk2(o[j][0][4 * g4 + 2] * inv, o[j][0][4 * g4 + 3] * inv);
            w1.x = pk2(o[j][1][4 * g4] * inv, o[j][1][4 * g4 + 1] * inv); w1.y = pk2(o[j][1][4 * g4 + 2] * inv, o[j][1][4 * g4 + 3] * inv);
            *(u32x2*)(op + 8 * g4 + 4 * hi2) = w0; *(u32x2*)(op + 32 + 8 * g4 + 4 * hi2) = w1;
        }
    }
#undef kn_g
#undef kp_g
#undef vt_g
}

DI float wave_sum(float v) {
#pragma unroll
    for (int o = 32; o >= 1; o >>= 1) v += __shfl_xor(v, o);
    return v;
}
DI int colmap(int mapid, int n) {
    switch (mapid) {
    case 1:
        if (n < 384) return 768 + n;
        if (n < 640) return 1152 + (n - 384);
        if (n < 672) { const int q = n - 640; return 1408 + (q & 1) * 16 + (q >> 1); }
        if (n < 768) return -1;
        if (n < 1152) return 384 + (n - 768);
        if (n < 1536) return n - 1152;
        return 1440 + (n - 1536);
    case 2: { const int j = n >> 1, hf = n & 1; return hf * 384 + j; }
    case 3: { const int hh = n / 96, d = n % 96; if (d < 64) return n; const int q = d - 64; return hh * 96 + 64 + (q & 1) * 16 + (q >> 1); }
    case 4: { if (n < 1024) { return (n >> 6) * 128 + (n & 63); } const int c = n - 1024; return (c >> 6) * 128 + 64 + (c & 63); }
    default: return n;
    }
}
DI void convT(bf16_t* out, const float* W, int K, int Nsrc, int Npad, const float* scale, int mapid, int gtid, int nthr) {
    const int total = Npad * (K >> 3);
    for (int idx = gtid; idx < total; idx += nthr) {
        const int q = idx >> 3, n = q % Npad, kc = (q / Npad) * 8 + (idx & 7), src = colmap(mapid, n);
        float v[8];
#pragma unroll
        for (int j = 0; j < 8; ++j) { const int k = kc * 8 + j; v[j] = src < 0 ? 0.f : W[(size_t)k * Nsrc + src] * (scale ? scale[k] : 1.0f); }
        *(u32x4*)(out + (size_t)n * K + kc * 8) = pack8(v);
    }
}
DI void sincos_rev(float rev, float& s, float& c) { const float f = rev - floorf(rev); s = __builtin_amdgcn_sinf(f); c = __builtin_amdgcn_cosf(f); }
struct S5c { float a, b, lr, li; };
DI S5c s5_load(const float* ldt, const float* lre, const float* lim, int layer, int d, int g, int n) {
    const int ig = (layer * 2 + d) * S5G + g; const float dt = __expf(ldt[ig]);
    S5c c; c.lr = lre[ig * 64 + n]; c.li = lim[ig * 64 + n]; c.a = c.lr * dt; c.b = c.li * dt; return c;
}
DI float2 cpowe(const S5c& c, float e) { const float mg = __expf(e * c.a); float s, co; sincos_rev(e * c.b * 0.15915494309189535f, s, co); return make_float2(mg * co, mg * s); }
DI float2 s5_coef(const S5c& c) {
    const float em1 = __expf(c.a) - 1.0f; float s, co, sh, ch; sincos_rev(c.b * 0.15915494309189535f, s, co); sincos_rev(c.b * 0.07957747154594768f, sh, ch); (void)ch;
    const float sh2 = sh * sh, nr = em1 * co - (sh2 + sh2), ni = (em1 + 1.f) * s, den = c.lr * c.lr + c.li * c.li;
    return make_float2((nr * c.lr + ni * c.li) / den, (ni * c.lr - nr * c.li) / den);
}
DI float2 cmul(float2 x, float2 y) { return make_float2(x.x * y.x - x.y * y.y, x.x * y.y + x.y * y.x); }

DI void phase_prep(const Params& P, int layer, int gtid, int nthr) {
    const int z = opq0();
#define IN(i) P.in[(i) + z]
    unsigned char* ws = P.ws + z; unsigned char* wb = ws + WS_W;
    const float *ldt = IN(I_LDT), *lre = IN(I_LRE), *lim = IN(I_LIM), *bre = IN(I_BRE), *bim = IN(I_BIM), *cre = IN(I_CRE), *cim = IN(I_CIM);
    convT((bf16_t*)(wb + W_IN), IN(I_WIN) + (size_t)layer * 1024 * IN_W, 1024, IN_W, INP, IN(I_GMIX) + layer * 1024, 1, gtid, nthr);
    convT((bf16_t*)(wb + W_GLU), IN(I_WGLU) + (size_t)layer * 384 * 768, 384, 768, 768, nullptr, 2, gtid, nthr);
    convT((bf16_t*)(wb + W_S5), IN(I_WS5) + (size_t)layer * 384 * 1024, 384, 1024, 1024, nullptr, 0, gtid, nthr);
    convT((bf16_t*)(wb + W_QB), IN(I_WQB) + (size_t)layer * 384 * 1536, 384, 1536, 1536, IN(I_GQ) + layer * 384, 3, gtid, nthr);
    convT((bf16_t*)(wb + W_KV), IN(I_WKVB) + (size_t)layer * 256 * 2048, 256, 2048, 2048, IN(I_GKV) + layer * 256, 4, gtid, nthr);
    convT((bf16_t*)(wb + W_O), IN(I_WO) + (size_t)layer * 1024 * 1024, 1024, 1024, 1024, nullptr, 0, gtid, nthr);
    convT((bf16_t*)(wb + W_OUT), IN(I_WOUT) + (size_t)layer * 1024 * 1024, 1024, 1024, 1024, nullptr, 0, gtid, nthr);
    convT((bf16_t*)(wb + W_UP), IN(I_WUP) + (size_t)layer * 1024 * 4096, 1024, 4096, 4096, IN(I_GMLP) + layer * 1024, 0, gtid, nthr);
    convT((bf16_t*)(wb + W_DOWN), IN(I_WDOWN) + (size_t)layer * 4096 * 1024, 4096, 1024, 1024, nullptr, 0, gtid, nthr);
    {
        const float* wf = IN(I_WFNET) + (size_t)layer * 384 * 1024; bf16_t* o = (bf16_t*)(wb + W_F);
        for (int idx = gtid; idx < 1024 * 768; idx += nthr) {
            const int oc = idx & 1023, kp = idx >> 10, type = kp >= 384, ch = kp - type * 384, g = ch >> 6, c = ch & 63;
            float acc = 0.f;
            for (int m = 0; m < 64; ++m) { float s, co; sincos_rev((float)((m * c) & 63) * (1.0f / 64.0f), s, co); acc += (type ? -s : co) * wf[(size_t)(g * 64 + m) * 1024 + oc]; }
            o[(size_t)oc * 768 + kp] = (bf16_t)f2bf(acc * 0.125f);
        }
    }
    if (layer == 0) {
        bf16_t* dft = (bf16_t*)(ws + WS_DFT);
        for (int idx = gtid; idx < DFTM * 512; idx += nthr) {
            const int r = idx >> 9, l0 = (idx & 511) * 8, type = r >= DFTR, k = r - type * DFTR; float v[8];
#pragma unroll
            for (int j = 0; j < 8; ++j) { float s, co; sincos_rev((float)((k * (l0 + j)) & 4095) * (1.0f / 4096.0f), s, co); v[j] = (type ? s : co) * (1.0f / 64.0f); }
            *(u32x4*)(dft + (size_t)r * 4096 + l0) = pack8(v);
        }
        float2* rope = (float2*)(ws + WS_ROPE);
        for (int idx = gtid; idx < 4096 * 16; idx += nthr) {
            const int pos = idx >> 4, i = idx & 15; const float inv = __expf(-(float)i * (9.210340371976184f / 16.0f)); float s, co; sincos_rev((float)pos * inv * 0.15915494309189535f, s, co);
            rope[idx] = make_float2(co, s);
        }
    }
    float* ktab = (float*)(ws + WS_KTAB);
    for (int idx = gtid; idx < S5G * 2 * 4 * 256; idx += nthr) {
        const int q = idx & 15, p = (idx >> 4) & 15, kb = (idx >> 8) & 3, d = (idx >> 10) & 1, g = idx >> 11;
        const int ig = (layer * 2 + d) * S5G + g; float acc[8];
#pragma unroll
        for (int k = 0; k < 8; ++k) acc[k] = 0.f;
        for (int n = 0; n < 64; ++n) {
            const S5c c = s5_load(ldt, lre, lim, layer, d, g, n);
            const float2 bb = cmul(s5_coef(c), make_float2(bre[((size_t)ig * 64 + n) * 16 + q], bim[((size_t)ig * 64 + n) * 16 + q]));
            const float2 cc = make_float2(cre[((size_t)ig * 16 + p) * 64 + n], cim[((size_t)ig * 16 + p) * 64 + n]);
            float2 w = cmul(cmul(cc, bb), cpowe(c, (float)(8 * kb)));
            const float2 l1 = cpowe(c, 1.0f);
#pragma unroll
            for (int k = 0; k < 8; ++k) { acc[k] += w.x; w = cmul(w, l1); }
        }
#pragma unroll
        for (int k = 0; k < 8; ++k) ktab[((((g * 2 + d) * 32 + 8 * kb + k) * 16 + p) * 16) + q] = acc[k];
    }
    bf16_t* bt1 = (bf16_t*)(ws + WS_BT1);
    for (int idx = gtid; idx < S5G * 256 * 512; idx += nthr) {
        const int q = idx & 15, s = (idx >> 4) & 31, j = (idx >> 9) & 255, g = idx >> 17, d = j >> 7, n = (j >> 1) & 63, ri = j & 1;
        const int ig = (layer * 2 + d) * S5G + g; const S5c c = s5_load(ldt, lre, lim, layer, d, g, n);
        const float2 bb = cmul(s5_coef(c), make_float2(bre[((size_t)ig * 64 + n) * 16 + q], bim[((size_t)ig * 64 + n) * 16 + q]));
        const float2 z = cmul(cpowe(c, d == 0 ? (float)(TCH - 1 - s) : (float)s), bb);
        bt1[idx] = (bf16_t)f2bf(ri ? z.y : z.x);
    }
    bf16_t* bt2 = (bf16_t*)(ws + WS_BT2);
    for (int idx = gtid; idx < S5G * 512 * 256; idx += nthr) {
        const int j = idx & 255, tp = (idx >> 8) & 511, g = idx >> 17, t = tp >> 4, p = tp & 15, d = j >> 7, n = (j >> 1) & 63, ri = j & 1;
        const int ig = (layer * 2 + d) * S5G + g; const S5c c = s5_load(ldt, lre, lim, layer, d, g, n);
        const float2 cc = make_float2(cre[((size_t)ig * 16 + p) * 64 + n], cim[((size_t)ig * 16 + p) * 64 + n]);
        const float2 z = cmul(cc, cpowe(c, d == 0 ? (float)(t + 1) : (float)(TCH - t)));
        bt2[((size_t)g * 512 + tp) * 768 + 512 + j] = (bf16_t)f2bf(ri ? -z.y : z.x);
    }
#undef IN
}
DI void phase_toeplitz(const Params& P, int gtid, int nthr) {
    const int z = opq0(); const float* ktab = (const float*)(P.ws + z + WS_KTAB); bf16_t* bt2 = (bf16_t*)(P.ws + z + WS_BT2);
    for (int idx = gtid; idx < S5G * 512 * 64; idx += nthr) {
        const int kc = idx & 63, tp = (idx >> 6) & 511, g = idx >> 15, t = tp >> 4, p = tp & 15, s = kc >> 1, q0 = (kc & 1) * 8;
        float v[8];
#pragma unroll
        for (int j = 0; j < 8; ++j) {
            float x = 0.f;
            if (s <= t) x += ktab[(((g * 2 + 0) * 32 + (t - s)) * 16 + p) * 16 + q0 + j];
            if (s >= t) x += ktab[(((g * 2 + 1) * 32 + (s - t)) * 16 + p) * 16 + q0 + j];
            v[j] = x;
        }
        *(u32x4*)(bt2 + ((size_t)g * 512 + tp) * 768 + kc * 8) = pack8(v);
    }
}
DI void phase_norm_x(const float* src_lo, const float* src_hi, int split_row, int row0, bf16_t* xb, int gw, int ngw, int lane) {
    for (int r = gw; r < MC; r += ngw) {
        const int R = row0 + r; const float* src = (R < split_row ? src_lo + (size_t)R * 1024 : src_hi + (size_t)(R - split_row) * 1024);
        f32x4 v[4]; float ss = 0.f;
#pragma unroll
        for (int j = 0; j < 4; ++j) { v[j] = *(const f32x4*)(src + j * 256 + lane * 4); ss += v[j][0] * v[j][0] + v[j][1] * v[j][1] + v[j][2] * v[j][2] + v[j][3] * v[j][3]; }
        ss = wave_sum(ss); const float rs = rsqrtf(ldexpf(ss + 1024.0f * EPS, -10));
#pragma unroll
        for (int j = 0; j < 4; ++j) { u32x2 w; w.x = pk2(v[j][0] * rs, v[j][1] * rs); w.y = pk2(v[j][2] * rs, v[j][3] * rs); *(u32x2*)(xb + (size_t)r * 1024 + j * 256 + lane * 4) = w; }
    }
}
DI void phase_norm_bf(bf16_t* x, int ncol, int gw, int ngw, int lane) {
    const int nj = ncol / 128;
    for (int r = gw; r < MC; r += ngw) {
        unsigned* row = (unsigned*)(x + (size_t)r * ncol); unsigned w[3]; float ss = 0.f;
#pragma unroll
        for (int j = 0; j < 3; ++j) if (j < nj) { w[j] = row[j * 64 + lane]; const float a = bflo(w[j]), b = bfhi(w[j]); ss += a * a + b * b; }
        ss = wave_sum(ss); const float rs = rsqrtf((ss + (float)ncol * EPS) * (ncol == 384 ? (1.0f / 384.0f) : (1.0f / 256.0f)));
#pragma unroll
        for (int j = 0; j < 3; ++j) if (j < nj) row[j * 64 + lane] = pk2(bflo(w[j]) * rs, bfhi(w[j]) * rs);
    }
}
DI void phase_s5_scan(const Params& P, int layer, int t) {
    if (t >= CSEQ * S5G * 2 * 64 * 8) return;
    const int n = (t & 7) | (((t >> 6) & 7) << 3), j = (t >> 3) & 7, rest = t >> 9, d = rest & 1, g = (rest >> 1) % S5G, bl = (rest >> 1) / S5G;
    const int z = opq0(); const S5c c = s5_load(P.in[I_LDT + z], P.in[I_LRE + z], P.in[I_LIM + z], layer, d, g, n);
    const float2 lt = cpowe(c, (float)TCH), lt16 = cpowe(c, (float)(16 * TCH));
    const float* s = (const float*)(P.ws + z + WS_S) + ((size_t)g * 512 + bl * 128) * 256 + d * 128 + n * 2;
    bf16_t* u2 = (bf16_t*)(P.ws + z + WS_U2) + ((size_t)g * 512 + bl * 128) * U2LD + 512 + d * 128 + n * 2;
    float2 sv[16], pf[16];
#pragma unroll
    for (int i = 0; i < 16; ++i) { const int k = 16 * j + i, cidx = d == 0 ? k : NCH - 1 - k; sv[i] = *(const float2*)(s + (size_t)cidx * 256); }
    float2 H = make_float2(0.f, 0.f);
#pragma unroll
    for (int i = 0; i < 16; ++i) { pf[i] = H; const float2 nh = cmul(lt, H); H = make_float2(nh.x + sv[i].x, nh.y + sv[i].y); }
    const int lane = t & 63;
    float2 C = make_float2(0.f, 0.f), mine = make_float2(0.f, 0.f);
#pragma unroll
    for (int m = 0; m < 8; ++m) {
        if (m == j) mine = C;
        const float ex = __shfl(H.x, (lane & 0x7) | (m << 3) | (lane & 0x38 & 0) , 64), ey = __shfl(H.y, (lane & 0x7) | (m << 3), 64);
        const float2 nc = cmul(lt16, C); C = make_float2(nc.x + ex, nc.y + ey);
    }
    float2 W = mine;
#pragma unroll
    for (int i = 0; i < 16; ++i) {
        const int k = 16 * j + i, cidx = d == 0 ? k : NCH - 1 - k;
        *(unsigned*)(u2 + (size_t)cidx * U2LD) = pk2(W.x + pf[i].x, W.y + pf[i].y);
        W = cmul(lt, W);
    }
}

DI unsigned xb_ld(unsigned* p)              { return __hip_atomic_load(p, __ATOMIC_RELAXED, __HIP_MEMORY_SCOPE_AGENT); }
DI unsigned xb_add(unsigned* p, unsigned v) { return __hip_atomic_fetch_add(p, v, __ATOMIC_RELAXED, __HIP_MEMORY_SCOPE_AGENT); }
DI void flat_barrier(unsigned char* wsb, LAS unsigned char* ldsb) {
    asm volatile("s_waitcnt vmcnt(0)" ::: "memory");
    __syncthreads();
    if (tid_opq() == 0) {
        unsigned* cnt = (unsigned*)(wsb + opq0() + WS_BAR) + 64;
        const unsigned G = gridDim.x;
        __builtin_amdgcn_fence(__ATOMIC_RELEASE, "agent");
        asm volatile("s_waitcnt vmcnt(0)" ::: "memory");
        volatile LAS unsigned* st = (volatile LAS unsigned*)(ldsb + 131072);
        const unsigned k = st[0] + 1u; st[0] = k;
        (void)xb_add(cnt, 1u);
        const unsigned target = k * G;
        unsigned sp = 0u;
        while (xb_ld(cnt) < target) { __builtin_amdgcn_s_sleep(1); if (++sp > (1u << 24)) break; }
        __builtin_amdgcn_fence(__ATOMIC_ACQUIRE, "agent");
        asm volatile("s_waitcnt vmcnt(0)" ::: "memory");
    }
    __syncthreads();
}

#ifndef PHM
#define PHM 0xffffffffu
#endif
#define PH(k) if constexpr (((PHM) >> (k)) & 1u)
constexpr int LDS_BYTES = 135168;
__global__ void __launch_bounds__(512, 2) mega(Params P) {
    extern __shared__ __attribute__((aligned(16))) unsigned char smem_raw[];
    LAS unsigned char* lds = (LAS unsigned char*)smem_raw;
    cg::grid_group grid = cg::this_grid();
    const int G = gridDim.x, blk = blockIdx.x;
    Sched S;
#define TID_VARS const int tid = tid_opq(), lane = tid & 63, wave = tid >> 6; (void)lane; (void)wave
#define WSP(T, off) ((T*)(P.ws + z + (off)))
#define WGT(off) ((const bf16_t*)(P.ws + z + WS_W + (off)))

    for (int layer = 0; layer < DEPTH; ++layer) {
        { TID_VARS; if (layer == 0 && tid == 0) *(volatile LAS unsigned*)(lds + 131072) = 0u; if (layer == 0 && blk == 0) { unsigned* bw = (unsigned*)(P.ws + opq0() + WS_BAR); for (int i = tid; i < 4096; i += 512) bw[i] = 0u; } phase_prep(P, layer, blk * 512 + tid, G * 512); }
        if (layer == 0) { const int z = opq0(); TID_VARS; phase_norm_x(P.in[I_XP + z], P.in[I_XS + z], MC, 0, WSP(bf16_t, WS_VT), blk * 8 + wave, G * 8, lane); }
        if (layer == 0) grid.sync(); else flat_barrier(P.ws, lds);
        { TID_VARS; phase_toeplitz(P, blk * 512 + tid, G * 512); }
        for (int ch = 0; ch < NCHUNK; ++ch) {
            const int row0 = ch * MC;
            { const int z = opq0(); TID_VARS; if (tid < MC / 256) WSP(float, WS_RSS)[blk * (MC / 256) + tid] = 0.f; }
            PH(0) { const int z = opq0(); Gemm g{WSP(bf16_t, WS_VT), WGT(W_IN), 1024, 1024, 1024, 0, 0}; S.init(MC / 256, INP / 256, 1, G, blk, 0);
              EpiIn E{WSP(bf16_t, WS_CQ), WSP(bf16_t, WS_CKV), WSP(bf16_t, WS_KPE), WSP(bf16_t, WS_U2), WSP(bf16_t, WS_ZT), WSP(bf16_t, WS_GATE), WSP(const float2, WS_ROPE)}; pg8::gemm_phase(lds, g, S, E); }
            flat_barrier(P.ws, lds);
            PH(1) { const int z = opq0(); Gemm g{WSP(bf16_t, WS_DFT), WSP(bf16_t, WS_ZT), 4096, 4096, 4096, 0, 0}; S.init(DFTM / 256, CSEQ * FW / 256, 1, G, blk, 0);
              EpiDft E{WSP(bf16_t, WS_PQ)}; pg8::gemm_phase(lds, g, S, E); }
            PH(2) { const int z = opq0(); Gemm g{WSP(bf16_t, WS_U2), WSP(bf16_t, WS_BT1), U2LD, 512, 512, (size_t)512 * U2LD, (size_t)256 * 512}; S.init(2, 1, S5G, G, blk, 108);
              EpiS1 E{WSP(float, WS_S)}; pg8::gemm_phase(lds, g, S, E); }
            if (blk >= 100) {
                const int z = opq0(); TID_VARS;
                if (blk >= 156) { phase_norm_bf(WSP(bf16_t, WS_CQ), 384, (blk - 156) * 8 + wave, 100 * 8, lane); phase_norm_bf(WSP(bf16_t, WS_CKV), 256, (blk - 156) * 8 + wave, 100 * 8, lane); }
                asm volatile("s_waitcnt vmcnt(0)" ::: "memory"); __syncthreads();
                if (tid == 0) {
                    unsigned* fl = (unsigned*)(P.ws + z + WS_BAR) + 192; unsigned sp = 0u;
                    if (blk >= 156) { __builtin_amdgcn_fence(__ATOMIC_RELEASE, "agent"); asm volatile("s_waitcnt vmcnt(0)" ::: "memory"); (void)xb_add(fl, 1u); }
                    const unsigned want = 100u * (unsigned)(layer * NCHUNK + ch + 1);
                    while (xb_ld(fl) < want) { __builtin_amdgcn_s_sleep(2); if (++sp > (1u << 24)) break; }
                    __builtin_amdgcn_fence(__ATOMIC_ACQUIRE, "agent"); asm volatile("s_waitcnt vmcnt(0)" ::: "memory");
                }
                __syncthreads();
            }
            PH(4) { const int z = opq0(); Gemm g{WSP(bf16_t, WS_CQ), WGT(W_QB), 384, 384, 384, 0, 0}; S.init(MC / 256, 6, 1, 148, blk - 108, 0); if (blk < 108) { S.nwg = 0; S.c = 0; }
              EpiQ E{WSP(bf16_t, WS_Q), WSP(const float2, WS_ROPE)}; pg8::gemm_phase(lds, g, S, E); }
            PH(5) { const int z = opq0(); Gemm g{WSP(bf16_t, WS_CKV), WGT(W_KV), 256, 256, 256, 0, 0}; if (blk < 100) { S.init(1, 1, 1, 1, 0, 0); S.nwg = 0; } else if (blk < 108) { S.init(MC / 256, 8, 1, 8, blk - 100, 0); S.nwg = 8; } else { S.init(MC / 256, 8, 1, 148, blk - 108, 88); S.base = 8; }
              EpiKV E{WSP(bf16_t, WS_KN), WSP(bf16_t, WS_VT)}; pg8::gemm_phase(lds, g, S, E); }
            flat_barrier(P.ws, lds);
            { TID_VARS; const int b2 = (blk + 192) % G; phase_s5_scan(P, layer, (b2 < 192 ? b2 * 512 + tid : 1 << 30));
              asm volatile("s_waitcnt vmcnt(0)" ::: "memory"); __syncthreads();
              if (tid == 0 && b2 < 192) { __builtin_amdgcn_fence(__ATOMIC_RELEASE, "agent"); asm volatile("s_waitcnt vmcnt(0)" ::: "memory"); (void)xb_add((unsigned*)(P.ws + opq0() + WS_BAR) + 256, 1u); } }
            PH(3) { const int z = opq0(); Gemm g{WSP(bf16_t, WS_PQ), WGT(W_F), 768, 768, 768, 0, 0}; S.init(MC / 256, 4, 1, G, blk, 0);
              EpiMerge E{WSP(bf16_t, WS_GATE), WSP(bf16_t, WS_MRG), 0, 0}; pg8::gemm_phase(lds, g, S, E); }
            {
                TID_VARS;
                if (tid == 0) { unsigned* fl = (unsigned*)(P.ws + opq0() + WS_BAR) + 256; const unsigned want = 192u * (unsigned)(layer * NCHUNK + ch + 1); unsigned sp = 0u;
                    while (xb_ld(fl) < want) { __builtin_amdgcn_s_sleep(2); if (++sp > (1u << 24)) break; }
                    __builtin_amdgcn_fence(__ATOMIC_ACQUIRE, "agent"); asm volatile("s_waitcnt vmcnt(0)" ::: "memory"); }
                __syncthreads();
            }
            PH(6) { const int z = opq0(); Gemm g{WSP(bf16_t, WS_U2), WSP(bf16_t, WS_BT2), U2LD, 768, 768, (size_t)512 * U2LD, (size_t)512 * 768}; S.init(2, 2, S5G, G, blk, 0);
              EpiS2 E{WSP(bf16_t, WS_U2), P.in[I_SD + z] + layer * 384, WSP(bf16_t, WS_YS5)}; pg8::gemm_phase(lds, g, S, E); }
            {
                TID_VARS; asm volatile("s_waitcnt vmcnt(0)" ::: "memory"); __syncthreads();
                if (tid == 0 && blk < 2 * 2 * S5G) { __builtin_amdgcn_fence(__ATOMIC_RELEASE, "agent"); asm volatile("s_waitcnt vmcnt(0)" ::: "memory"); (void)xb_add((unsigned*)(P.ws + opq0() + WS_BAR) + 128, 1u); }
            }
            PH(7) { const int z = opq0();
              for (int i = 0;; ++i) {
                if (i >= (CSEQ * NH * 8) / 256 || G != 256) { if (G == 256) break; const int uidx0 = i * G + blk; if (uidx0 >= CSEQ * NH * 8) break; }
                const int xcd = blk & 7, slot = blk >> 3;
                const int uidx = G == 256 ? ((i * 32 + xcd * 4 + (slot >> 3)) << 3) + (slot & 7) : i * G + blk;
                const int bh = uidx >> 3, qb = uidx & 7;
                attn_unit(lds, WSP(bf16_t, WS_Q), WSP(bf16_t, WS_KN), WSP(bf16_t, WS_KPE), WSP(bf16_t, WS_VT), WSP(bf16_t, WS_XB), bh >> 4, bh & 15, qb);
              } }
            {
                TID_VARS;
                if (tid == 0) { unsigned* fl = (unsigned*)(P.ws + opq0() + WS_BAR) + 128; const unsigned want = (unsigned)(2 * 2 * S5G) * (unsigned)(layer * NCHUNK + ch + 1); unsigned sp = 0u;
                    while (xb_ld(fl) < want) { __builtin_amdgcn_s_sleep(2); if (++sp > (1u << 24)) break; }
                    __builtin_amdgcn_fence(__ATOMIC_ACQUIRE, "agent"); asm volatile("s_waitcnt vmcnt(0)" ::: "memory"); }
                __syncthreads();
            }
            PH(8) { const int z = opq0(); Gemm g{WSP(bf16_t, WS_YS5), WGT(W_GLU), 384, 384, 384, 0, 0}; S.init(MC / 256, 3, 1, 160, blk - 96, 0); if (blk < 96) { S.nwg = 0; S.c = 0; }
              EpiGlu E{WSP(bf16_t, WS_GLU)}; pg8::gemm_phase(lds, g, S, E); }
            flat_barrier(P.ws, lds);
            PH(9) { const int z = opq0(); Gemm g{WSP(bf16_t, WS_XB), WGT(W_O), 1024, 1024, 1024, 0, 0}; S.init(MC / 256, 4, 1, G, blk, 0);
              EpiMerge E{WSP(bf16_t, WS_GATE), WSP(bf16_t, WS_MRG), 2, 1}; pg8::gemm_phase(lds, g, S, E); }
            PH(10) { const int z = opq0(); Gemm g{WSP(bf16_t, WS_GLU), WGT(W_S5), 384, 384, 384, 0, 0}; S.init(MC / 256, 4, 1, G, blk, 0);
              EpiMerge E{WSP(bf16_t, WS_GATE), WSP(bf16_t, WS_MRG), 1, 1}; pg8::gemm_phase(lds, g, S, E); }
            {
                TID_VARS; pg8::Unit u0; S.init(MC / 256, 4, 1, G, blk, 0); const bool has = S.next(0, u0);
                asm volatile("s_waitcnt vmcnt(0)" ::: "memory"); __syncthreads();
                if (tid == 0 && has) {
                    unsigned* pc = (unsigned*)(P.ws + opq0() + WS_BAR) + 512 + 16 * u0.pm; unsigned sp = 0u;
                    __builtin_amdgcn_fence(__ATOMIC_RELEASE, "agent"); asm volatile("s_waitcnt vmcnt(0)" ::: "memory"); (void)xb_add(pc, 1u);
                    const unsigned want = 4u * (unsigned)(layer * NCHUNK + ch + 1);
                    while (xb_ld(pc) < want) { __builtin_amdgcn_s_sleep(1); if (++sp > (1u << 24)) break; }
                    __builtin_amdgcn_fence(__ATOMIC_ACQUIRE, "agent"); asm volatile("s_waitcnt vmcnt(0)" ::: "memory");
                }
                __syncthreads();
            }
            PH(11) { const int z = opq0(); Gemm g{WSP(bf16_t, WS_MRG), WGT(W_OUT), 1024, 1024, 1024, 0, 0}; S.init(MC / 256, 4, 1, G, blk, 0);
              const float* res = layer == 0 ? (ch == 0 ? P.in[I_XP + z] : P.in[I_XS + z] + (size_t)(row0 - MC) * 1024) : P.out + z + (size_t)row0 * 1024;
              EpiResN E{res, P.out + z + (size_t)row0 * 1024, WSP(bf16_t, WS_XB), WSP(float, WS_RSS)}; pg8::gemm_phase(lds, g, S, E); }
            flat_barrier(P.ws, lds);
            PH(12) { const int z = opq0(); Gemm g{WSP(bf16_t, WS_XB), WGT(W_UP), 1024, 1024, 1024, 0, 0}; S.init(MC / 256, 16, 1, G, blk, 0);
              EpiUpN E{WSP(bf16_t, WS_HID), WSP(const float, WS_RSS)}; pg8::gemm_phase(lds, g, S, E); }
            { const int z = opq0(); TID_VARS; const int nch = ch + 1 < NCHUNK ? ch + 1 : 0, nlayer = ch + 1 < NCHUNK ? layer : layer + 1;
              if (nlayer < DEPTH) {
                if (nlayer == 0) phase_norm_x(P.in[I_XP + z], P.in[I_XS + z], MC, nch * MC, WSP(bf16_t, WS_VT), blk * 8 + wave, G * 8, lane);
                else if (nch != ch || nlayer == layer) phase_norm_x(P.out + z, P.out + z, MTOT, nch * MC, WSP(bf16_t, WS_VT), blk * 8 + wave, G * 8, lane);
              } }
            flat_barrier(P.ws, lds);
            PH(13) { const int z = opq0(); Gemm g{WSP(bf16_t, WS_HID), WGT(W_DOWN), 4096, 4096, 4096, 0, 0}; S.init(MC / 256, 4, 1, G, blk, 0);
              EpiRes E{P.out + z + (size_t)row0 * 1024, P.out + z + (size_t)row0 * 1024}; pg8::gemm_phase(lds, g, S, E); }
            if (ch == NCHUNK - 1) flat_barrier(P.ws, lds);
        }
    }
    {
        const int z = opq0(); TID_VARS; const float* gf = P.in[I_GFIN + z];
        for (int r = blk * 8 + wave; r < MTOT; r += G * 8) {
            float* row = P.out + z + (size_t)r * 1024; f32x4 v[4]; float ss = 0.f;
#pragma unroll
            for (int j = 0; j < 4; ++j) { v[j] = *(const f32x4*)(row + j * 256 + lane * 4); ss += v[j][0] * v[j][0] + v[j][1] * v[j][1] + v[j][2] * v[j][2] + v[j][3] * v[j][3]; }
            ss = wave_sum(ss); const float rs = rsqrtf(ldexpf(ss + 1024.0f * EPS, -10));
#pragma unroll
            for (int j = 0; j < 4; ++j) { const f32x4 gg = *(const f32x4*)(gf + j * 256 + lane * 4); *(f32x4*)(row + j * 256 + lane * 4) = v[j] * rs * gg; }
        }
    }
#undef WSP
#undef WGT
}

extern "C" void kernel_launch(void* const* d_in, const int* in_sizes, int n_in, void* d_out, int out_size, void* d_ws, size_t ws_size, hipStream_t stream) {
    static int grid = 0;
    if (grid == 0) {
        if (n_in != 25 || out_size != MTOT * D || ws_size < WS_END) { fprintf(stderr, "kernel_launch: unexpected shapes (n_in %d out %d ws %zu)\n", n_in, out_size, ws_size); grid = -1; return; }
        int dev = 0, cus = 0, per_cu = 0;
        if (hipGetDevice(&dev) != hipSuccess || hipDeviceGetAttribute(&cus, hipDeviceAttributeMultiprocessorCount, dev) != hipSuccess) { grid = -1; return; }
        if (hipFuncSetAttribute((const void*)mega, hipFuncAttributeMaxDynamicSharedMemorySize, LDS_BYTES) != hipSuccess) { fprintf(stderr, "kernel_launch: hipFuncSetAttribute failed\n"); grid = -1; return; }
        if (hipOccupancyMaxActiveBlocksPerMultiprocessor(&per_cu, (const void*)mega, 512, LDS_BYTES) != hipSuccess || per_cu < 1) { fprintf(stderr, "kernel_launch: occupancy query says %d\n", per_cu); per_cu = 1; }
        (void)hipGetLastError();
        grid = cus * 1;
    }
    if (grid < 0) return;
    Params p{};
    for (int i = 0; i < 25; ++i) p.in[i] = (const float*)d_in[i];
    p.out = (float*)d_out; p.ws = (unsigned char*)d_ws;
    void* args[] = {&p};
    hipError_t e = hipLaunchCooperativeKernel((const void*)mega, dim3(grid), dim3(512), args, LDS_BYTES, stream);
    if (e != hipSuccess) fprintf(stderr, "cooperative launch failed: %s (grid %d)\n", hipGetErrorString(e), grid);
}
```

```cpp
#include <hip/hip_runtime.h>
#include <hip/hip_cooperative_groups.h>
#include <cstdio>
#include <cstdint>
namespace cg = cooperative_groups;

#define DI __device__ __forceinline__
#define LAS __attribute__((address_space(3)))
typedef unsigned short bf16_t;
typedef short bf16x8 __attribute__((ext_vector_type(8)));
typedef short s16x4 __attribute__((ext_vector_type(4)));
typedef float f32x4 __attribute__((ext_vector_type(4)));
typedef float f32x16 __attribute__((ext_vector_type(16)));
typedef unsigned u32x4 __attribute__((ext_vector_type(4)));
typedef unsigned u32x2 __attribute__((ext_vector_type(2)));

constexpr int D = 1024, SEQ = 4096, NSEQ = 12, MTOT = NSEQ * SEQ, DEPTH = 2;
constexpr int CSEQ = 4, MC = CSEQ * SEQ, NCHUNK = NSEQ / CSEQ;
constexpr int FW = 384, S5W = 384, QL = 384, KVL = 256, NH = 16, DQK = 96, DV = 64, DFF = 4096;
constexpr int IN_W = 4512, INP = 4608;
constexpr int S5G = 24, S5P = 16, S5N = 64, TCH = 32, NCH = SEQ / TCH;
constexpr int U2LD = TCH * S5P + 256;
constexpr int DFTR = 2304, DFTM = 2 * DFTR;
constexpr float EPS = 1e-6f;
constexpr float QSCALE = 0.10206207261596577f * 1.4426950408889634f;

constexpr size_t MiB = 1u << 20;
constexpr size_t WS_ROPE = 0, WS_KTAB = MiB / 2;
constexpr size_t WS_W = 2 * MiB;
constexpr size_t W_IN = 0, W_F = W_IN + (size_t)INP * 1024 * 2, W_GLU = W_F + 1024 * 768 * 2, W_S5 = W_GLU + 768 * 384 * 2,
                 W_QB = W_S5 + 1024 * 384 * 2, W_KV = W_QB + 1536 * 384 * 2, W_O = W_KV + 2048 * 256 * 2, W_OUT = W_O + 1024 * 1024 * 2,
                 W_UP = W_OUT + 1024 * 1024 * 2, W_DOWN = W_UP + (size_t)4096 * 1024 * 2, W_END = W_DOWN + (size_t)4096 * 1024 * 2;
static_assert(W_END <= 34 * MiB, "weights");
constexpr size_t WS_DFT = 36 * MiB, WS_BT1 = 72 * MiB, WS_BT2 = 78 * MiB;
constexpr size_t WS_XB = 96 * MiB  , WS_ZT = 128 * MiB, WS_U2 = 140 * MiB, WS_S = 158 * MiB, WS_CQ = 170 * MiB, WS_CKV = 182 * MiB,
                 WS_KPE = 190 * MiB, WS_RSS = 191 * MiB  , WS_GATE = 192 * MiB, WS_HID = 288 * MiB  , WS_PQ = 288 * MiB, WS_YS5 = 312 * MiB, WS_GLU = 324 * MiB,
                 WS_Q = 336 * MiB, WS_KN = 384 * MiB, WS_VT = 416 * MiB, WS_MRG = 448 * MiB, WS_BAR = 480 * MiB, WS_END = 480 * MiB + 16384;

struct Params {
    const float* in[25];
    float* out;
    unsigned char* ws;
};
enum { I_XP = 0, I_XS, I_GMIX, I_WIN, I_WFNET, I_LRE, I_LIM, I_LDT, I_BRE, I_BIM, I_CRE, I_CIM, I_SD, I_WGLU, I_WS5, I_GQ, I_WQB, I_GKV, I_WKVB,
       I_WO, I_WOUT, I_GMLP, I_WUP, I_WDOWN, I_GFIN };

DI int opq0() { int z = 0; asm volatile("" : "+s"(z)); return z; }
DI int opqv(int x) { asm volatile("" : "+v"(x)); return x; }
DI int tid_opq() { int t = threadIdx.x; asm volatile("" : "+v"(t)); return t; }
typedef __bf16 bf16x2_t __attribute__((ext_vector_type(2)));
typedef float f32x2_t __attribute__((ext_vector_type(2)));
DI unsigned pk2(float lo, float hi) { const f32x2_t v = {lo, hi}; return __builtin_bit_cast(unsigned, __builtin_convertvector(v, bf16x2_t)); }
DI unsigned f2bf(float f) { return pk2(f, 0.f) & 0xffffu; }
DI float bf2f(unsigned h) { return __builtin_bit_cast(float, h << 16); }
DI float bflo(unsigned w) { return __builtin_bit_cast(float, w << 16); }
DI float bfhi(unsigned w) { return __builtin_bit_cast(float, w & 0xffff0000u); }
DI float sigmoidf_(float v) { return __builtin_amdgcn_rcpf(1.0f + __builtin_amdgcn_exp2f(v * -1.4426950408889634f)); }
DI float gelu_tanh(float x) { const float u2 = 1.5957691216057308f * (x + 0.044715f * x * x * x); return x * sigmoidf_(u2); }

namespace pg8 {
constexpr int BM = 256, BK = 64, HALF = 128, HTB = HALF * BK * 2, STAGE_BYTES = 8 * HTB, NXCD = 8, WGM = 8;
DI int lds_byte(int r, int c) { const int st = (r >> 4) * 2 + (c >> 5), rr = r & 15, cc = c & 31, ob = rr * 64 + cc * 2; return st * 1024 + (ob ^ (((ob >> 9) & 1) << 5)); }
DI void stage_rc(int b, int& R, int& C) { const int st = b / 1024, sb = b % 1024, swz = sb ^ (((sb >> 9) & 1) << 5); R = (st >> 1) * 16 + swz / 64; C = (st & 1) * 32 + (swz % 64) / 2; }
DI int perm32(int rho) { const int n = rho >> 4, i = rho & 15; return 8 * (i >> 2) + 4 * n + (i & 3); }

struct Unit { int pm, pn, z; };
struct Gemm { const bf16_t* A; const bf16_t* Bt; int lda, ldb, K; size_t sA, sB; };

struct Sched {
    int nM, nN, per, nwg, G, c, base;
    DI void init(int nM_, int nN_, int nB_, int G_, int blk, int off) { nM = nM_; nN = nN_; per = nM * nN; nwg = per * nB_; G = G_; c = (blk + G_ - (off % G_)) % G_; base = 0; }
    DI bool next(int i, Unit& u) const {
        const long L = (long)base + (long)i * G + c; if (L >= nwg) return false;
        const int z = (int)(L / per); int wgid = (int)(L % per);
        if (per >= 64) { const int q = per / NXCD, r = per % NXCD, xcd = wgid % NXCD, off = wgid / NXCD; wgid = (xcd < r ? xcd * (q + 1) : r * (q + 1) + (xcd - r) * q) + off; }
        const int nig = WGM * nN, gid = wgid / nig, fm = gid * WGM, gsz = (nM - fm) < WGM ? (nM - fm) : WGM;
        u.pm = fm + ((wgid % nig) % gsz); u.pn = (wgid % nig) / gsz; u.z = z; return true;
    }
};

template <class Epi>
DI void gemm_phase(LAS unsigned char* lds, const Gemm g, const Sched& S, const Epi& E) {
    const int tid = tid_opq(), wid = __builtin_amdgcn_readfirstlane(tid >> 6), lane = tid & 63, wr = wid >> 2, wc = wid & 3, fr = lane & 15, fq = lane >> 4;
    const int K = g.K, nt = K / BK;
    unsigned voffA[2], voffB[2];
#pragma unroll
    for (int i = 0; i < 2; ++i) { int R, C; stage_rc(tid * 16 + i * 8192, R, C); const int Rb = (R & ~31) + perm32(R & 31);
        voffA[i] = (unsigned)(R * g.lda + C) * 2u; voffB[i] = (unsigned)(Rb * g.ldb + C) * 2u; }
    const size_t kstep = (size_t)(BK * 2);
    const size_t hstepA = (size_t)HALF * g.lda * 2, hstepB = (size_t)HALF * g.ldb * 2;
    const size_t tstepA = 2 * hstepA, tstepB = 2 * hstepB;
    const unsigned ldsw = (unsigned)wid * 1024u;
    const int aoff = lds_byte(wr * 64 + fr, fq * 8), boff = lds_byte(wc * 32 + fr, fq * 8);
#define PG8_SA(b, h) (((b) * 2 + (h)) * HTB)
#define PG8_SB(b, h) ((4 + (b) * 2 + (h)) * HTB)
#define PG8_STAGE(bufoff, gbase, voff) do { _Pragma("unroll") for (int _i = 0; _i < 2; ++_i) \
        __builtin_amdgcn_global_load_lds((const unsigned*)((const char*)(gbase) + (voff)[_i]), (LAS unsigned*)(lds + (bufoff) + ldsw + _i * 8192), 16, 0, 0); } while (0)
#define PG8_LDA(dst, b, h) do { _Pragma("unroll") for (int m = 0; m < 4; ++m) _Pragma("unroll") for (int k = 0; k < 2; ++k) dst[m][k] = *(const LAS bf16x8*)(lds + PG8_SA(b, h) + aoff + m * 2048 + k * 1024); } while (0)
#define PG8_LDB(dst, b, h) do { _Pragma("unroll") for (int n = 0; n < 2; ++n) _Pragma("unroll") for (int k = 0; k < 2; ++k) dst[n][k] = *(const LAS bf16x8*)(lds + PG8_SB(b, h) + boff + n * 2048 + k * 1024); } while (0)
#define PG8_MMA(ai, bj, At, Bt) do { __builtin_amdgcn_s_setprio(1); _Pragma("unroll") for (int m = 0; m < 4; ++m) _Pragma("unroll") for (int n = 0; n < 2; ++n) _Pragma("unroll") for (int k = 0; k < 2; ++k) \
        acc[ai][bj][m][n] = __builtin_amdgcn_mfma_f32_16x16x32_bf16(Bt[n][k], At[m][k], acc[ai][bj][m][n], 0, 0, 0); __builtin_amdgcn_s_setprio(0); } while (0)
#define PG8_WAIT_V(n) asm volatile("s_waitcnt vmcnt(" #n ")" ::: "memory")
#define PG8_WAIT_L(n) asm volatile("s_waitcnt lgkmcnt(" #n ")" ::: "memory")
#define PG8_BAR __builtin_amdgcn_s_barrier()
#define PG8_SCHED __builtin_amdgcn_sched_barrier(0)
    Unit cur, nxt; int ui = 0;
    if (!S.next(0, cur)) return;
    f32x4 acc[2][2][4][2];
#pragma unroll
    for (int a = 0; a < 2; ++a)
#pragma unroll
        for (int b = 0; b < 2; ++b)
#pragma unroll
            for (int m = 0; m < 4; ++m)
#pragma unroll
                for (int n = 0; n < 2; ++n) acc[a][b][m][n] = (f32x4){0.f, 0.f, 0.f, 0.f};
    bf16x8 At[4][2], B0[2][2], B1[2][2];
    const char* cA = (const char*)g.A + (size_t)cur.z * g.sA * 2 + (size_t)cur.pm * tstepA;
    const char* cB = (const char*)g.Bt + (size_t)cur.z * g.sB * 2 + (size_t)cur.pn * tstepB;
    PG8_STAGE(PG8_SB(0, 0), cB, voffB); PG8_STAGE(PG8_SB(0, 1), cB + hstepB, voffB); PG8_STAGE(PG8_SA(0, 0), cA, voffA); PG8_STAGE(PG8_SA(0, 1), cA + hstepA, voffA);
    if (wr == 1) PG8_BAR;
    PG8_WAIT_V(2); PG8_BAR;
    PG8_STAGE(PG8_SB(1, 0), cB + kstep, voffB); PG8_STAGE(PG8_SA(1, 0), cA + kstep, voffA); PG8_STAGE(PG8_SB(1, 1), cB + hstepB + kstep, voffB);
    PG8_WAIT_V(6); PG8_BAR;
    for (;;) {
        const bool has_next = S.next(ui + 1, nxt);
        const char* nA = has_next ? (const char*)g.A + (size_t)nxt.z * g.sA * 2 + (size_t)nxt.pm * tstepA : cA;
        const char* nB = has_next ? (const char*)g.Bt + (size_t)nxt.z * g.sB * 2 + (size_t)nxt.pn * tstepB : cB;
#pragma clang loop unroll(disable)
        for (int t = 0; t < nt; t += 2) {
            const bool last = (t == nt - 2);
            const char* a1 = cA + (size_t)(t + 1) * kstep;
            const char* a2 = last ? nA : cA + (size_t)(t + 2) * kstep; const char* b2 = last ? nB : cB + (size_t)(t + 2) * kstep;
            const char* a3 = a2 + kstep; const char* b3 = b2 + kstep;
            PG8_LDB(B0, 0, 0); PG8_LDB(B1, 0, 1); PG8_SCHED; PG8_LDA(At, 0, 0); PG8_STAGE(PG8_SA(1, 1), a1 + hstepA, voffA);
            PG8_WAIT_V(8); PG8_WAIT_L(0); PG8_BAR; PG8_MMA(0, 0, At, B0); PG8_MMA(0, 1, At, B1); PG8_BAR; PG8_SCHED;
            PG8_LDA(At, 0, 1); PG8_STAGE(PG8_SB(0, 0), b2, voffB); PG8_STAGE(PG8_SB(0, 1), b2 + hstepB, voffB); PG8_STAGE(PG8_SA(0, 0), a2, voffA);
            PG8_WAIT_V(8); PG8_WAIT_L(0); PG8_BAR; PG8_MMA(1, 0, At, B0); PG8_MMA(1, 1, At, B1); PG8_BAR; PG8_SCHED;
            PG8_LDB(B0, 1, 0); PG8_LDB(B1, 1, 1); PG8_SCHED; PG8_LDA(At, 1, 0); PG8_STAGE(PG8_SA(0, 1), a2 + hstepA, voffA);
            PG8_WAIT_V(8); PG8_WAIT_L(0); PG8_BAR; PG8_MMA(0, 0, At, B0); PG8_MMA(0, 1, At, B1); PG8_BAR; PG8_SCHED;
            PG8_LDA(At, 1, 1); PG8_STAGE(PG8_SB(1, 0), b3, voffB); PG8_STAGE(PG8_SB(1, 1), b3 + hstepB, voffB); PG8_STAGE(PG8_SA(1, 0), a3, voffA);
            PG8_WAIT_V(8); PG8_WAIT_L(0); PG8_BAR; PG8_MMA(1, 0, At, B0); PG8_MMA(1, 1, At, B1); PG8_BAR; PG8_SCHED;
        }
        if (wr == 0) PG8_BAR;
        { int fr2 = fr, fq2 = fq; asm volatile("" : "+v"(fr2), "+v"(fq2)); E(acc, cur, wr, wc, fr2, fq2); }
        if (!has_next) break;
#pragma unroll
        for (int a = 0; a < 2; ++a)
#pragma unroll
            for (int b = 0; b < 2; ++b)
#pragma unroll
                for (int m = 0; m < 4; ++m)
#pragma unroll
                    for (int n = 0; n < 2; ++n) acc[a][b][m][n] = (f32x4){0.f, 0.f, 0.f, 0.f};
        cur = nxt; cA = nA; cB = nB; ++ui;
        if (wr == 1) PG8_BAR;
    }
    PG8_WAIT_V(0);
    PG8_BAR;
#undef PG8_SA
#undef PG8_SB
#undef PG8_STAGE
#undef PG8_LDA
#undef PG8_LDB
#undef PG8_MMA
#undef PG8_WAIT_V
#undef PG8_WAIT_L
#undef PG8_BAR
#undef PG8_SCHED
}
}
using pg8::Unit; using pg8::Gemm; using pg8::Sched;
typedef f32x4 Acc[2][2][4][2];

#define EPI_FOR(u) \
    _Pragma("unroll") for (int ai = 0; ai < 2; ++ai) _Pragma("unroll") for (int m = 0; m < 4; ++m) _Pragma("unroll") for (int bj = 0; bj < 2; ++bj)
#define EPI_ROW(u) ((u).pm * 256 + ai * 128 + wr * 64 + m * 16 + fr)
#define EPI_CB(u) ((u).pn * 256 + bj * 128 + wc * 32)
#define EPI_COL(u) (EPI_CB(u) + 8 * fq)
#define EPI_V(v) float v[8] = {acc[ai][bj][m][0][0], acc[ai][bj][m][0][1], acc[ai][bj][m][0][2], acc[ai][bj][m][0][3], acc[ai][bj][m][1][0], acc[ai][bj][m][1][1], acc[ai][bj][m][1][2], acc[ai][bj][m][1][3]}
DI u32x4 pack8(const float* v) { u32x4 w; w.x = pk2(v[0], v[1]); w.y = pk2(v[2], v[3]); w.z = pk2(v[4], v[5]); w.w = pk2(v[6], v[7]); return w; }

struct EpiIn {
    bf16_t *cq, *ckv, *kpe, *u2, *zt, *gate; const float2* rope;
    DI void operator()(const Acc& acc, const Unit& u, int wr, int wc, int fr, int fq) const {
        const int K384 = opqv(384), K1152 = opqv(1152);
        EPI_FOR(u) {
            const int row = EPI_ROW(u), cb = EPI_CB(u), col = cb + 8 * fq; EPI_V(v);
            const int bl = row >> 12, pos = row & 4095;
            if (cb >= 1536) {
#pragma unroll
                for (int j = 0; j < 8; ++j) v[j] = sigmoidf_(v[j]);
                *(u32x4*)(gate + (size_t)row * 3072 + (col - 1536)) = pack8(v);
            } else if (cb < 384) {
                *(u32x4*)(cq + (size_t)row * 384 + col) = pack8(v);
            } else if (cb < 640) {
                *(u32x4*)(ckv + (size_t)row * 256 + (col - 384)) = pack8(v);
            } else if (cb < 672) {
                const int i0 = (col - 640) >> 1; float o[8];
#pragma unroll
                for (int j = 0; j < 4; ++j) { const float2 cs = rope[pos * 16 + i0 + j]; o[2 * j] = v[2 * j] * cs.x - v[2 * j + 1] * cs.y; o[2 * j + 1] = v[2 * j] * cs.y + v[2 * j + 1] * cs.x; }
                *(u32x4*)(kpe + (size_t)row * 32 + (col - 640)) = pack8(o);
            } else if (cb < 768) {
            } else if (cb < 1152) {
                const int ch = col - 768, g = ch >> 4, q0 = ch & 15, c = pos >> 5, t = pos & 31;
                *(u32x4*)(u2 + ((size_t)g * 512 + bl * 128 + c) * U2LD + t * 16 + q0) = pack8(v);
            } else {
                const int ch = col - K1152;
#pragma unroll
                for (int j = 0; j < 8; ++j) zt[((size_t)(bl * K384 + ch + j)) * 4096 + pos] = (bf16_t)f2bf(v[j]);
            }
        }
    }
};
struct EpiDft {
    bf16_t* pq;
    DI void operator()(const Acc& acc, const Unit& u, int wr, int wc, int fr, int fq) const {
        const int K384 = opqv(384), K2304 = opqv(DFTR);
        EPI_FOR(u) {
            const int row = EPI_ROW(u), col = EPI_COL(u); EPI_V(v);
            const int type = row >= DFTR, k = row - type * K2304, bl = col / 384, ch = col - bl * K384;
            if (k <= 2048) {
                *(u32x4*)(pq + ((size_t)bl * 4096 + k) * 768 + type * K384 + ch) = pack8(v);
                if (k >= 1 && k <= 2047) {
                    if (type) {
#pragma unroll
                        for (int j = 0; j < 8; ++j) v[j] = -v[j];
                    }
                    *(u32x4*)(pq + ((size_t)bl * 4096 + (4096 - k)) * 768 + type * K384 + ch) = pack8(v);
                }
            }
        }
    }
};
struct EpiS1 {
    float* s;
    DI void operator()(const Acc& acc, const Unit& u, int wr, int wc, int fr, int fq) const {
        EPI_FOR(u) {
            const int row = EPI_ROW(u), col = EPI_COL(u);
            float* p = s + ((size_t)u.z * 512 + row) * 256 + col;
            *(f32x4*)p = acc[ai][bj][m][0]; *(f32x4*)(p + 4) = acc[ai][bj][m][1];
        }
    }
};
struct EpiS2 {
    const bf16_t* u2; const float* dsk; bf16_t* ys;
    DI void operator()(const Acc& acc, const Unit& u, int wr, int wc, int fr, int fq) const {
        EPI_FOR(u) {
            const int row = EPI_ROW(u), col = EPI_COL(u); EPI_V(v);
            const int t = col >> 4, p0 = col & 15, g = u.z;
            const u32x4 uu = *(const u32x4*)(u2 + ((size_t)g * 512 + row) * U2LD + col);
            const float uf[8] = {bflo(uu.x), bfhi(uu.x), bflo(uu.y), bfhi(uu.y), bflo(uu.z), bfhi(uu.z), bflo(uu.w), bfhi(uu.w)};
#pragma unroll
            for (int j = 0; j < 8; ++j) v[j] = gelu_tanh(v[j] + dsk[g * 16 + p0 + j] * uf[j]);
            *(u32x4*)(ys + ((size_t)row * 32 + t) * 384 + g * 16 + p0) = pack8(v);
        }
    }
};
struct EpiMerge {
    const bf16_t* gate; bf16_t* mrg; int gi; int accum;
    DI void operator()(const Acc& acc, const Unit& u, int wr, int wc, int fr, int fq) const {
        EPI_FOR(u) {
            const int row = EPI_ROW(u), col = EPI_COL(u); EPI_V(v);
            const u32x4 gg = *(const u32x4*)(gate + (size_t)row * 3072 + gi * 1024 + col);
            const float gf[8] = {bflo(gg.x), bfhi(gg.x), bflo(gg.y), bfhi(gg.y), bflo(gg.z), bfhi(gg.z), bflo(gg.w), bfhi(gg.w)};
            bf16_t* mp = mrg + (size_t)row * 1024 + col;
            if (accum) {
                const u32x4 oo = *(const u32x4*)mp;
                const float of[8] = {bflo(oo.x), bfhi(oo.x), bflo(oo.y), bfhi(oo.y), bflo(oo.z), bfhi(oo.z), bflo(oo.w), bfhi(oo.w)};
#pragma unroll
                for (int j = 0; j < 8; ++j) v[j] = of[j] + gf[j] * v[j];
            } else {
#pragma unroll
                for (int j = 0; j < 8; ++j) v[j] = gf[j] * v[j];
            }
            *(u32x4*)mp = pack8(v);
        }
    }
};
struct EpiQ {
    bf16_t* q; const float2* rope;
    DI void operator()(const Acc& acc, const Unit& u, int wr, int wc, int fr, int fq) const {
        EPI_FOR(u) {
            const int row = EPI_ROW(u), col = EPI_COL(u); EPI_V(v);
            const int pos = row & 4095, d = col % 96;
            if ((EPI_CB(u) % 96) >= 64) {
                const int i0 = (d - 64) >> 1; float o[8];
#pragma unroll
                for (int j = 0; j < 4; ++j) { const float2 cs = rope[pos * 16 + i0 + j]; o[2 * j] = v[2 * j] * cs.x - v[2 * j + 1] * cs.y; o[2 * j + 1] = v[2 * j] * cs.y + v[2 * j + 1] * cs.x; }
#pragma unroll
                for (int j = 0; j < 8; ++j) v[j] = o[j];
            }
#pragma unroll
            for (int j = 0; j < 8; ++j) v[j] *= QSCALE;
            *(u32x4*)(q + (size_t)row * 1536 + col) = pack8(v);
        }
    }
};
struct EpiKV {
    bf16_t *kn, *vt;
    DI void operator()(const Acc& acc, const Unit& u, int wr, int wc, int fr, int fq) const {
        EPI_FOR(u) {
            const int row = EPI_ROW(u), col = EPI_COL(u); EPI_V(v);
            const int bl = row >> 12, pos = row & 4095;
            if (EPI_CB(u) < 1024) {
                const int h = col >> 6, d0 = col & 63;
                *(u32x4*)(kn + (((size_t)(bl * 16 + h)) * 4096 + pos) * 64 + d0) = pack8(v);
            } else {
                const int c2 = col - 1024, h = c2 >> 6, d0 = c2 & 63;
#pragma unroll
                for (int j = 0; j < 8; ++j) vt[(((size_t)(bl * 16 + h)) * 64 + d0 + j) * 4096 + pos] = (bf16_t)f2bf(v[j]);
            }
        }
    }
};
struct EpiGlu {
    bf16_t* o;
    DI void operator()(const Acc& acc, const Unit& u, int wr, int wc, int fr, int fq) const {
        EPI_FOR(u) {
            const int row = EPI_ROW(u), col = EPI_COL(u); EPI_V(v);
            u32x2 w; w.x = pk2(v[0] * sigmoidf_(v[1]), v[2] * sigmoidf_(v[3])); w.y = pk2(v[4] * sigmoidf_(v[5]), v[6] * sigmoidf_(v[7]));
            *(u32x2*)(o + (size_t)row * 384 + (col >> 1)) = w;
        }
    }
};
struct EpiRes {
    const float* res; float* out;
    DI void operator()(const Acc& acc, const Unit& u, int wr, int wc, int fr, int fq) const {
        EPI_FOR(u) {
            const int row = EPI_ROW(u), col = EPI_COL(u);
            const float* rp = res + (size_t)row * 1024 + col; float* op = out + (size_t)row * 1024 + col;
            const f32x4 r0 = *(const f32x4*)rp, r1 = *(const f32x4*)(rp + 4);
            *(f32x4*)op = r0 + acc[ai][bj][m][0]; *(f32x4*)(op + 4) = r1 + acc[ai][bj][m][1];
        }
    }
};
struct EpiUp {
    bf16_t* h;
    DI void operator()(const Acc& acc, const Unit& u, int wr, int wc, int fr, int fq) const {
        EPI_FOR(u) {
            const int row = EPI_ROW(u), col = EPI_COL(u); EPI_V(v);
#pragma unroll
            for (int j = 0; j < 8; ++j) { const float r = v[j] > 0.f ? v[j] : 0.f; v[j] = r * r; }
            *(u32x4*)(h + (size_t)row * 4096 + col) = pack8(v);
        }
    }
};

struct EpiResN {
    const float* res; float* out; bf16_t* xb; float* rss;
    DI void operator()(const Acc& acc, const Unit& u, int wr, int wc, int fr, int fq) const {
#pragma unroll
        for (int ai = 0; ai < 2; ++ai)
#pragma unroll
            for (int m = 0; m < 4; ++m) {
                const int row = EPI_ROW(u); float part = 0.f;
#pragma unroll
                for (int bj = 0; bj < 2; ++bj) {
                    const int col = EPI_COL(u);
                    const float* rp = res + (size_t)row * 1024 + col; float* op = out + (size_t)row * 1024 + col;
                    const f32x4 o0 = *(const f32x4*)rp + acc[ai][bj][m][0], o1 = *(const f32x4*)(rp + 4) + acc[ai][bj][m][1];
                    *(f32x4*)op = o0; *(f32x4*)(op + 4) = o1;
                    part += o0[0] * o0[0] + o0[1] * o0[1] + o0[2] * o0[2] + o0[3] * o0[3] + o1[0] * o1[0] + o1[1] * o1[1] + o1[2] * o1[2] + o1[3] * o1[3];
                    const float v[8] = {o0[0], o0[1], o0[2], o0[3], o1[0], o1[1], o1[2], o1[3]};
                    *(u32x4*)(xb + (size_t)row * 1024 + col) = pack8(v);
                }
                part += __shfl_xor(part, 16); part += __shfl_xor(part, 32);
                if (fq == 0) atomicAdd(rss + row, part);
            }
    }
};
struct EpiUpN {
    bf16_t* h; const float* rss;
    DI void operator()(const Acc& acc, const Unit& u, int wr, int wc, int fr, int fq) const {
#pragma unroll
        for (int ai = 0; ai < 2; ++ai)
#pragma unroll
            for (int m = 0; m < 4; ++m) {
                const int row = EPI_ROW(u); const float r2 = __builtin_amdgcn_rcpf(ldexpf(rss[row], -10) + EPS);
#pragma unroll
                for (int bj = 0; bj < 2; ++bj) {
                    const int col = EPI_COL(u); EPI_V(v);
#pragma unroll
                    for (int j = 0; j < 8; ++j) { const float r = v[j] > 0.f ? v[j] : 0.f; v[j] = r * r * r2; }
                    *(u32x4*)(h + (size_t)row * 4096 + col) = pack8(v);
                }
            }
    }
};

constexpr int KPITCH = 208, VPITCH = 136, KBUF = 64 * KPITCH, VBUF = 64 * VPITCH;
DI void attn_unit(LAS unsigned char* lds, const bf16_t* Q, const bf16_t* Kn, const bf16_t* Kpe, const bf16_t* Vt, bf16_t* O, int b, int h, int qb) {
    const int tid = tid_opq(), wid = __builtin_amdgcn_readfirstlane(tid >> 6), lane = tid & 63, r32 = lane & 31, hi = lane >> 5;
    LAS unsigned char* Ks = lds; LAS unsigned char* Vs = lds + 2 * KBUF;
    const int qrow = b * 4096 + qb * 512 + wid * 64 + r32;
    bf16x8 qf[2][6];
#pragma unroll
    for (int j = 0; j < 2; ++j)
#pragma unroll
        for (int s = 0; s < 6; ++s) qf[j][s] = *(const bf16x8*)(Q + (size_t)(qrow + 32 * j) * 1536 + h * 96 + 16 * s + 8 * hi);
    const bf16_t* kn_b = Kn + (size_t)(b * 16 + h) * 4096 * 64; const bf16_t* kp_b = Kpe + (size_t)b * 4096 * 32; const bf16_t* vt_b = Vt + (size_t)(b * 16 + h) * 64 * 4096;
    const unsigned kn_o = (unsigned)((tid >> 3) * 64 + (tid & 7) * 8), kp_o = (unsigned)((tid >> 2) * 32 + (tid & 3) * 8), vt_o = (unsigned)((tid >> 3) * 4096 + (tid & 7) * 8);
#define kn_g (kn_b + kn_o)
#define kp_g (kp_b + kp_o)
#define vt_g (vt_b + vt_o)
    const int kn_l = (tid >> 3) * KPITCH + (tid & 7) * 16, kp_l = (tid >> 2) * KPITCH + 128 + (tid & 3) * 16, vt_l = (tid >> 3) * VPITCH + (tid & 7) * 16;
    u32x4 rk = *(const u32x4*)kn_g, rp = (u32x4){0, 0, 0, 0}, rv = *(const u32x4*)vt_g;
    if (tid < 256) rp = *(const u32x4*)kp_g;
    f32x16 o[2][2];
#pragma unroll
    for (int j = 0; j < 2; ++j)
#pragma unroll
        for (int i = 0; i < 16; ++i) { o[j][0][i] = 0.f; o[j][1][i] = 0.f; }
    float mrun[2] = {0.f, 0.f}, lsum[2] = {0.f, 0.f};
    __syncthreads();
    *(LAS u32x4*)(Ks + kn_l) = rk; if (tid < 256) *(LAS u32x4*)(Ks + kp_l) = rp;
    *(LAS u32x2*)(Vs + vt_l) = (u32x2){rv.x, rv.y}; *(LAS u32x2*)(Vs + vt_l + 8) = (u32x2){rv.z, rv.w};
    __syncthreads();
    for (int kt = 0; kt < 64; ++kt) {
        const int buf = kt & 1;
        LAS unsigned char* kb = Ks + buf * KBUF; LAS unsigned char* vb = Vs + buf * VBUF;
        f32x16 s[2][2];
#pragma unroll
        for (int j = 0; j < 2; ++j) { const float negm = -mrun[j];
#pragma unroll
            for (int i = 0; i < 16; ++i) { s[j][0][i] = negm; s[j][1][i] = negm; } }
        if (wid < 4) __builtin_amdgcn_s_setprio(3); else __builtin_amdgcn_s_setprio(1);
#pragma unroll
        for (int t = 0; t < 6; ++t) {
            const bf16x8 ka0 = *(const LAS bf16x8*)(kb + r32 * KPITCH + (16 * t + 8 * hi) * 2);
            const bf16x8 ka1 = *(const LAS bf16x8*)(kb + (32 + r32) * KPITCH + (16 * t + 8 * hi) * 2);
#pragma unroll
            for (int j = 0; j < 2; ++j) {
                s[j][0] = __builtin_amdgcn_mfma_f32_32x32x16_bf16(ka0, qf[j][t], s[j][0], 0, 0, 0);
                s[j][1] = __builtin_amdgcn_mfma_f32_32x32x16_bf16(ka1, qf[j][t], s[j][1], 0, 0, 0);
            }
        }
        __builtin_amdgcn_s_setprio(0);
        __builtin_amdgcn_sched_barrier(0);
        if (kt + 1 < 64) {
            rk = *(const u32x4*)(kn_b + (kn_o + (unsigned)(kt + 1) * 4096u)); rv = *(const u32x4*)(vt_b + (vt_o + (unsigned)(kt + 1) * 64u));
            if (tid < 256) rp = *(const u32x4*)(kp_b + (kp_o + (unsigned)(kt + 1) * 2048u));
        }
        __builtin_amdgcn_sched_barrier(0);
        float mx[2];
#pragma unroll
        for (int j = 0; j < 2; ++j) {
            mx[j] = fmaxf(s[j][0][0], s[j][1][0]);
#pragma unroll
            for (int i = 1; i < 16; ++i) mx[j] = fmaxf(mx[j], fmaxf(s[j][0][i], s[j][1][i]));
        }
        { const float o0 = __shfl_xor(mx[0], 32), o1 = __shfl_xor(mx[1], 32); mx[0] = fmaxf(mx[0], o0); mx[1] = fmaxf(mx[1], o1); }
        if (kt == 0 || __builtin_amdgcn_ballot_w64(fmaxf(mx[0], mx[1]) > 6.0f) != 0ull) {
#pragma unroll
            for (int j = 0; j < 2; ++j) {
                const float dlt = kt == 0 ? mx[j] : fmaxf(mx[j], 0.f), alpha = __builtin_amdgcn_exp2f(-dlt);
                mrun[j] += dlt; lsum[j] *= alpha;
#pragma unroll
                for (int i = 0; i < 16; ++i) { s[j][0][i] -= dlt; s[j][1][i] -= dlt; o[j][0][i] *= alpha; o[j][1][i] *= alpha; }
            }
        }
#pragma unroll
        for (int j = 0; j < 2; ++j) {
            float ps = 0.f;
#pragma unroll
            for (int i = 0; i < 16; ++i) { s[j][0][i] = __builtin_amdgcn_exp2f(s[j][0][i]); s[j][1][i] = __builtin_amdgcn_exp2f(s[j][1][i]); ps += s[j][0][i] + s[j][1][i]; }
            lsum[j] += ps;
        }
        if (wid < 4) __builtin_amdgcn_s_setprio(3); else __builtin_amdgcn_s_setprio(1);
#pragma unroll
        for (int kbk = 0; kbk < 2; ++kbk) {
#pragma unroll
            for (int t = 0; t < 2; ++t) {
                const int koff = (32 * kbk + 16 * t + 4 * hi) * 2;
                const s16x4 a0l = *(const LAS s16x4*)(vb + r32 * VPITCH + koff), a0h = *(const LAS s16x4*)(vb + r32 * VPITCH + koff + 16);
                const s16x4 a1l = *(const LAS s16x4*)(vb + (32 + r32) * VPITCH + koff), a1h = *(const LAS s16x4*)(vb + (32 + r32) * VPITCH + koff + 16);
                const bf16x8 va0 = __builtin_shufflevector(a0l, a0h, 0, 1, 2, 3, 4, 5, 6, 7), va1 = __builtin_shufflevector(a1l, a1h, 0, 1, 2, 3, 4, 5, 6, 7);
#pragma unroll
                for (int j = 0; j < 2; ++j) {
                    u32x4 pw;
                    pw.x = pk2(s[j][kbk][8 * t], s[j][kbk][8 * t + 1]); pw.y = pk2(s[j][kbk][8 * t + 2], s[j][kbk][8 * t + 3]);
                    pw.z = pk2(s[j][kbk][8 * t + 4], s[j][kbk][8 * t + 5]); pw.w = pk2(s[j][kbk][8 * t + 6], s[j][kbk][8 * t + 7]);
                    const bf16x8 pb = __builtin_bit_cast(bf16x8, pw);
                    o[j][0] = __builtin_amdgcn_mfma_f32_32x32x16_bf16(va0, pb, o[j][0], 0, 0, 0);
                    o[j][1] = __builtin_amdgcn_mfma_f32_32x32x16_bf16(va1, pb, o[j][1], 0, 0, 0);
                }
            }
        }
        __builtin_amdgcn_s_setprio(0);
        if (kt + 1 < 64) {
            LAS unsigned char* kn2 = Ks + (buf ^ 1) * KBUF; LAS unsigned char* vn2 = Vs + (buf ^ 1) * VBUF;
            *(LAS u32x4*)(kn2 + kn_l) = rk; if (tid < 256) *(LAS u32x4*)(kn2 + kp_l) = rp;
            *(LAS u32x2*)(vn2 + vt_l) = (u32x2){rv.x, rv.y}; *(LAS u32x2*)(vn2 + vt_l + 8) = (u32x2){rv.z, rv.w};
        }
        __syncthreads();
    }
    const int tid2 = tid_opq(), lane2 = tid2 & 63, hi2 = lane2 >> 5;
    const int qrow2 = b * 4096 + qb * 512 + __builtin_amdgcn_readfirstlane(tid2 >> 6) * 64 + (lane2 & 31);
#pragma unroll
    for (int j = 0; j < 2; ++j) {
        const float l = lsum[j] + __shfl_xor(lsum[j], 32), inv = 1.0f / l;
        bf16_t* op = O + (size_t)(qrow2 + 32 * j) * 1024 + h * 64;
#pragma unroll
        for (int g4 = 0; g4 < 4; ++g4) {
            u32x2 w0, w1;
            w0.x = pk2(o[j][0][4 * g4] * inv, o[j][0][4 * g4 + 1] * inv); w0.y = pk2(o[j][0][4 * g4 + 2] * inv, o[j][0][4 * g4 + 3] * inv);
            w1.x = pk2(o[j][1][4 * g4] * inv, o[j][1][4 * g4 + 1] * inv); w1.y = pk2(o[j][1][4 * g4 + 2] * inv, o[j][1][4 * g4 + 3] * inv);
            *(u32x2*)(op + 8 * g4 + 4 * hi2) = w0; *(u32x2*)(op + 32 + 8 * g4 + 4 * hi2) = w1;
        }
    }
#undef kn_g
#undef kp_g
#undef vt_g
}

DI float wave_sum(float v) {
#pragma unroll
    for (int o = 32; o >= 1; o >>= 1) v += __shfl_xor(v, o);
    return v;
}
DI int colmap(int mapid, int n) {
    switch (mapid) {
    case 1:
        if (n < 384) return 768 + n;
        if (n < 640) return 1152 + (n - 384);
        if (n < 672) { const int q = n - 640; return 1408 + (q & 1) * 16 + (q >> 1); }
        if (n < 768) return -1;
        if (n < 1152) return 384 + (n - 768);
        if (n < 1536) return n - 1152;
        return 1440 + (n - 1536);
    case 2: { const int j = n >> 1, hf = n & 1; return hf * 384 + j; }
    case 3: { const int hh = n / 96, d = n % 96; if (d < 64) return n; const int q = d - 64; return hh * 96 + 64 + (q & 1) * 16 + (q >> 1); }
    case 4: { if (n < 1024) { return (n >> 6) * 128 + (n & 63); } const int c = n - 1024; return (c >> 6) * 128 + 64 + (c & 63); }
    default: return n;
    }
}
DI void convT(bf16_t* out, const float* W, int K, int Nsrc, int Npad, const float* scale, int mapid, int gtid, int nthr) {
    const int total = Npad * (K >> 3);
    for (int idx = gtid; idx < total; idx += nthr) {
        const int q = idx >> 3, n = q % Npad, kc = (q / Npad) * 8 + (idx & 7), src = colmap(mapid, n);
        float v[8];
#pragma unroll
        for (int j = 0; j < 8; ++j) { const int k = kc * 8 + j; v[j] = src < 0 ? 0.f : W[(size_t)k * Nsrc + src] * (scale ? scale[k] : 1.0f); }
        *(u32x4*)(out + (size_t)n * K + kc * 8) = pack8(v);
    }
}
DI void sincos_rev(float rev, float& s, float& c) { const float f = rev - floorf(rev); s = __builtin_amdgcn_sinf(f); c = __builtin_amdgcn_cosf(f); }
struct S5c { float a, b, lr, li; };
DI S5c s5_load(const float* ldt, const float* lre, const float* lim, int layer, int d, int g, int n) {
    const int ig = (layer * 2 + d) * S5G + g; const float dt = __expf(ldt[ig]);
    S5c c; c.lr = lre[ig * 64 + n]; c.li = lim[ig * 64 + n]; c.a = c.lr * dt; c.b = c.li * dt; return c;
}
DI float2 cpowe(const S5c& c, float e) { const float mg = __expf(e * c.a); float s, co; sincos_rev(e * c.b * 0.15915494309189535f, s, co); return make_float2(mg * co, mg * s); }
DI float2 s5_coef(const S5c& c) {
    const float em1 = __expf(c.a) - 1.0f; float s, co, sh, ch; sincos_rev(c.b * 0.15915494309189535f, s, co); sincos_rev(c.b * 0.07957747154594768f, sh, ch); (void)ch;
    const float sh2 = sh * sh, nr = em1 * co - (sh2 + sh2), ni = (em1 + 1.f) * s, den = c.lr * c.lr + c.li * c.li;
    return make_float2((nr * c.lr + ni * c.li) / den, (ni * c.lr - nr * c.li) / den);
}
DI float2 cmul(float2 x, float2 y) { return make_float2(x.x * y.x - x.y * y.y, x.x * y.y + x.y * y.x); }

DI void phase_prep(const Params& P, int layer, int gtid, int nthr) {
    const int z = opq0();
#define IN(i) P.in[(i) + z]
    unsigned char* ws = P.ws + z; unsigned char* wb = ws + WS_W;
    const float *ldt = IN(I_LDT), *lre = IN(I_LRE), *lim = IN(I_LIM), *bre = IN(I_BRE), *bim = IN(I_BIM), *cre = IN(I_CRE), *cim = IN(I_CIM);
    convT((bf16_t*)(wb + W_IN), IN(I_WIN) + (size_t)layer * 1024 * IN_W, 1024, IN_W, INP, IN(I_GMIX) + layer * 1024, 1, gtid, nthr);
    convT((bf16_t*)(wb + W_GLU), IN(I_WGLU) + (size_t)layer * 384 * 768, 384, 768, 768, nullptr, 2, gtid, nthr);
    convT((bf16_t*)(wb + W_S5), IN(I_WS5) + (size_t)layer * 384 * 1024, 384, 1024, 1024, nullptr, 0, gtid, nthr);
    convT((bf16_t*)(wb + W_QB), IN(I_WQB) + (size_t)layer * 384 * 1536, 384, 1536, 1536, IN(I_GQ) + layer * 384, 3, gtid, nthr);
    convT((bf16_t*)(wb + W_KV), IN(I_WKVB) + (size_t)layer * 256 * 2048, 256, 2048, 2048, IN(I_GKV) + layer * 256, 4, gtid, nthr);
    convT((bf16_t*)(wb + W_O), IN(I_WO) + (size_t)layer * 1024 * 1024, 1024, 1024, 1024, nullptr, 0, gtid, nthr);
    convT((bf16_t*)(wb + W_OUT), IN(I_WOUT) + (size_t)layer * 1024 * 1024, 1024, 1024, 1024, nullptr, 0, gtid, nthr);
    convT((bf16_t*)(wb + W_UP), IN(I_WUP) + (size_t)layer * 1024 * 4096, 1024, 4096, 4096, IN(I_GMLP) + layer * 1024, 0, gtid, nthr);
    convT((bf16_t*)(wb + W_DOWN), IN(I_WDOWN) + (size_t)layer * 4096 * 1024, 4096, 1024, 1024, nullptr, 0, gtid, nthr);
    {
        const float* wf = IN(I_WFNET) + (size_t)layer * 384 * 1024; bf16_t* o = (bf16_t*)(wb + W_F);
        for (int idx = gtid; idx < 1024 * 768; idx += nthr) {
            const int oc = idx & 1023, kp = idx >> 10, type = kp >= 384, ch = kp - type * 384, g = ch >> 6, c = ch & 63;
            float acc = 0.f;
            for (int m = 0; m < 64; ++m) { float s, co; sincos_rev((float)((m * c) & 63) * (1.0f / 64.0f), s, co); acc += (type ? -s : co) * wf[(size_t)(g * 64 + m) * 1024 + oc]; }
            o[(size_t)oc * 768 + kp] = (bf16_t)f2bf(acc * 0.125f);
        }
    }
    if (layer == 0) {
        bf16_t* dft = (bf16_t*)(ws + WS_DFT);
        for (int idx = gtid; idx < DFTM * 512; idx += nthr) {
            const int r = idx >> 9, l0 = (idx & 511) * 8, type = r >= DFTR, k = r - type * DFTR; float v[8];
#pragma unroll
            for (int j = 0; j < 8; ++j) { float s, co; sincos_rev((float)((k * (l0 + j)) & 4095) * (1.0f / 4096.0f), s, co); v[j] = (type ? s : co) * (1.0f / 64.0f); }
            *(u32x4*)(dft + (size_t)r * 4096 + l0) = pack8(v);
        }
        float2* rope = (float2*)(ws + WS_ROPE);
        for (int idx = gtid; idx < 4096 * 16; idx += nthr) {
            const int pos = idx >> 4, i = idx & 15; const float inv = __expf(-(float)i * (9.210340371976184f / 16.0f)); float s, co; sincos_rev((float)pos * inv * 0.15915494309189535f, s, co);
            rope[idx] = make_float2(co, s);
        }
    }
    float* ktab = (float*)(ws + WS_KTAB);
    for (int idx = gtid; idx < S5G * 2 * 4 * 256; idx += nthr) {
        const int q = idx & 15, p = (idx >> 4) & 15, kb = (idx >> 8) & 3, d = (idx >> 10) & 1, g = idx >> 11;
        const int ig = (layer * 2 + d) * S5G + g; float acc[8];
#pragma unroll
        for (int k = 0; k < 8; ++k) acc[k] = 0.f;
        for (int n = 0; n < 64; ++n) {
            const S5c c = s5_load(ldt, lre, lim, layer, d, g, n);
            const float2 bb = cmul(s5_coef(c), make_float2(bre[((size_t)ig * 64 + n) * 16 + q], bim[((size_t)ig * 64 + n) * 16 + q]));
            const float2 cc = make_float2(cre[((size_t)ig * 16 + p) * 64 + n], cim[((size_t)ig * 16 + p) * 64 + n]);
            float2 w = cmul(cmul(cc, bb), cpowe(c, (float)(8 * kb)));
            const float2 l1 = cpowe(c, 1.0f);
#pragma unroll
            for (int k = 0; k < 8; ++k) { acc[k] += w.x; w = cmul(w, l1); }
        }
#pragma unroll
        for (int k = 0; k < 8; ++k) ktab[((((g * 2 + d) * 32 + 8 * kb + k) * 16 + p) * 16) + q] = acc[k];
    }
    bf16_t* bt1 = (bf16_t*)(ws + WS_BT1);
    for (int idx = gtid; idx < S5G * 128 * 32; idx += nthr) {
        const int s = idx & 31, jp = (idx >> 5) & 127, g = idx >> 12, d = jp >> 6, n = jp & 63;
        const int ig = (layer * 2 + d) * S5G + g; const S5c c = s5_load(ldt, lre, lim, layer, d, g, n);
        const float2 zc = cmul(cpowe(c, d == 0 ? (float)(TCH - 1 - s) : (float)s), s5_coef(c));
        float vr[16], vi[16];
#pragma unroll
        for (int q = 0; q < 16; ++q) { const float2 z = cmul(zc, make_float2(bre[((size_t)ig * 64 + n) * 16 + q], bim[((size_t)ig * 64 + n) * 16 + q])); vr[q] = z.x; vi[q] = z.y; }
        bf16_t* o0 = bt1 + (((size_t)(g * 256 + 2 * jp)) * 32 + s) * 16; bf16_t* o1 = o0 + 512;
        *(u32x4*)o0 = pack8(vr); *(u32x4*)(o0 + 8) = pack8(vr + 8); *(u32x4*)o1 = pack8(vi); *(u32x4*)(o1 + 8) = pack8(vi + 8);
    }
    bf16_t* bt2 = (bf16_t*)(ws + WS_BT2);
    for (int idx = gtid; idx < S5G * 512 * 256; idx += nthr) {
        const int j = idx & 255, tp = (idx >> 8) & 511, g = idx >> 17, t = tp >> 4, p = tp & 15, d = j >> 7, n = (j >> 1) & 63, ri = j & 1;
        const int ig = (layer * 2 + d) * S5G + g; const S5c c = s5_load(ldt, lre, lim, layer, d, g, n);
        const float2 cc = make_float2(cre[((size_t)ig * 16 + p) * 64 + n], cim[((size_t)ig * 16 + p) * 64 + n]);
        const float2 z = cmul(cc, cpowe(c, d == 0 ? (float)(t + 1) : (float)(TCH - t)));
        bt2[((size_t)g * 512 + tp) * 768 + 512 + j] = (bf16_t)f2bf(ri ? -z.y : z.x);
    }
#undef IN
}
DI void phase_toeplitz(const Params& P, int gtid, int nthr) {
    const int z = opq0(); const float* ktab = (const float*)(P.ws + z + WS_KTAB); bf16_t* bt2 = (bf16_t*)(P.ws + z + WS_BT2);
    for (int idx = gtid; idx < S5G * 512 * 64; idx += nthr) {
        const int kc = idx & 63, tp = (idx >> 6) & 511, g = idx >> 15, t = tp >> 4, p = tp & 15, s = kc >> 1, q0 = (kc & 1) * 8;
        float v[8];
#pragma unroll
        for (int j = 0; j < 8; ++j) {
            float x = 0.f;
            if (s <= t) x += ktab[(((g * 2 + 0) * 32 + (t - s)) * 16 + p) * 16 + q0 + j];
            if (s >= t) x += ktab[(((g * 2 + 1) * 32 + (s - t)) * 16 + p) * 16 + q0 + j];
            v[j] = x;
        }
        *(u32x4*)(bt2 + ((size_t)g * 512 + tp) * 768 + kc * 8) = pack8(v);
    }
}
DI void phase_norm_x(const float* src_lo, const float* src_hi, int split_row, int row0, bf16_t* xb, int gw, int ngw, int lane) {
    for (int r = gw; r < MC; r += ngw) {
        const int R = row0 + r; const float* src = (R < split_row ? src_lo + (size_t)R * 1024 : src_hi + (size_t)(R - split_row) * 1024);
        f32x4 v[4]; float ss = 0.f;
#pragma unroll
        for (int j = 0; j < 4; ++j) { v[j] = *(const f32x4*)(src + j * 256 + lane * 4); ss += v[j][0] * v[j][0] + v[j][1] * v[j][1] + v[j][2] * v[j][2] + v[j][3] * v[j][3]; }
        ss = wave_sum(ss); const float rs = rsqrtf(ldexpf(ss + 1024.0f * EPS, -10));
#pragma unroll
        for (int j = 0; j < 4; ++j) { u32x2 w; w.x = pk2(v[j][0] * rs, v[j][1] * rs); w.y = pk2(v[j][2] * rs, v[j][3] * rs); *(u32x2*)(xb + (size_t)r * 1024 + j * 256 + lane * 4) = w; }
    }
}
DI void phase_norm_bf(bf16_t* x, int ncol, int gw, int ngw, int lane) {
    const int nj = ncol / 128;
    for (int r = gw; r < MC; r += ngw) {
        unsigned* row = (unsigned*)(x + (size_t)r * ncol); unsigned w[3]; float ss = 0.f;
#pragma unroll
        for (int j = 0; j < 3; ++j) if (j < nj) { w[j] = row[j * 64 + lane]; const float a = bflo(w[j]), b = bfhi(w[j]); ss += a * a + b * b; }
        ss = wave_sum(ss); const float rs = rsqrtf((ss + (float)ncol * EPS) * (ncol == 384 ? (1.0f / 384.0f) : (1.0f / 256.0f)));
#pragma unroll
        for (int j = 0; j < 3; ++j) if (j < nj) row[j * 64 + lane] = pk2(bflo(w[j]) * rs, bfhi(w[j]) * rs);
    }
}
DI void phase_s5_scan(const Params& P, int layer, int t) {
    if (t >= CSEQ * S5G * 2 * 64 * 8) return;
    const int n = (t & 7) | (((t >> 6) & 7) << 3), j = (t >> 3) & 7, rest = t >> 9, d = rest & 1, g = (rest >> 1) % S5G, bl = (rest >> 1) / S5G;
    const int z = opq0(); const S5c c = s5_load(P.in[I_LDT + z], P.in[I_LRE + z], P.in[I_LIM + z], layer, d, g, n);
    const float2 lt = cpowe(c, (float)TCH), lt16 = cpowe(c, (float)(16 * TCH));
    const float* s = (const float*)(P.ws + z + WS_S) + ((size_t)g * 512 + bl * 128) * 256 + d * 128 + n * 2;
    bf16_t* u2 = (bf16_t*)(P.ws + z + WS_U2) + ((size_t)g * 512 + bl * 128) * U2LD + 512 + d * 128 + n * 2;
    float2 sv[16], pf[16];
#pragma unroll
    for (int i = 0; i < 16; ++i) { const int k = 16 * j + i, cidx = d == 0 ? k : NCH - 1 - k; sv[i] = *(const float2*)(s + (size_t)cidx * 256); }
    float2 H = make_float2(0.f, 0.f);
#pragma unroll
    for (int i = 0; i < 16; ++i) { pf[i] = H; const float2 nh = cmul(lt, H); H = make_float2(nh.x + sv[i].x, nh.y + sv[i].y); }
    const int lane = t & 63;
    float2 C = make_float2(0.f, 0.f), mine = make_float2(0.f, 0.f);
#pragma unroll
    for (int m = 0; m < 8; ++m) {
        if (m == j) mine = C;
        const float ex = __shfl(H.x, (lane & 0x7) | (m << 3) | (lane & 0x38 & 0) , 64), ey = __shfl(H.y, (lane & 0x7) | (m << 3), 64);
        const float2 nc = cmul(lt16, C); C = make_float2(nc.x + ex, nc.y + ey);
    }
    float2 W = mine;
#pragma unroll
    for (int i = 0; i < 16; ++i) {
        const int k = 16 * j + i, cidx = d == 0 ? k : NCH - 1 - k;
        *(unsigned*)(u2 + (size_t)cidx * U2LD) = pk2(W.x + pf[i].x, W.y + pf[i].y);
        W = cmul(lt, W);
    }
}

DI unsigned xb_ld(unsigned* p)              { return __hip_atomic_load(p, __ATOMIC_RELAXED, __HIP_MEMORY_SCOPE_AGENT); }
DI unsigned xb_add(unsigned* p, unsigned v) { return __hip_atomic_fetch_add(p, v, __ATOMIC_RELAXED, __HIP_MEMORY_SCOPE_AGENT); }
DI void flat_barrier(unsigned char* wsb, LAS unsigned char* ldsb) {
    asm volatile("s_waitcnt vmcnt(0)" ::: "memory");
    __syncthreads();
    if (tid_opq() == 0) {
        unsigned* cnt = (unsigned*)(wsb + opq0() + WS_BAR) + 64;
        const unsigned G = gridDim.x;
        __builtin_amdgcn_fence(__ATOMIC_RELEASE, "agent");
        asm volatile("s_waitcnt vmcnt(0)" ::: "memory");
        volatile LAS unsigned* st = (volatile LAS unsigned*)(ldsb + 131072);
        const unsigned k = st[0] + 1u; st[0] = k;
        (void)xb_add(cnt, 1u);
        const unsigned target = k * G;
        unsigned sp = 0u;
        while (xb_ld(cnt) < target) { __builtin_amdgcn_s_sleep(1); if (++sp > (1u << 24)) break; }
        __builtin_amdgcn_fence(__ATOMIC_ACQUIRE, "agent");
        asm volatile("s_waitcnt vmcnt(0)" ::: "memory");
    }
    __syncthreads();
}

#ifndef PHM
#define PHM 0xffffffffu
#endif
#define PH(k) if constexpr (((PHM) >> (k)) & 1u)
constexpr int LDS_BYTES = 135168;
__global__ void __launch_bounds__(512, 2) mega(Params P) {
    extern __shared__ __attribute__((aligned(16))) unsigned char smem_raw[];
    LAS unsigned char* lds = (LAS unsigned char*)smem_raw;
    cg::grid_group grid = cg::this_grid();
    const int G = gridDim.x, blk = blockIdx.x;
    Sched S;
#define TID_VARS const int tid = tid_opq(), lane = tid & 63, wave = tid >> 6; (void)lane; (void)wave
#define WSP(T, off) ((T*)(P.ws + z + (off)))
#define WGT(off) ((const bf16_t*)(P.ws + z + WS_W + (off)))

    for (int layer = 0; layer < DEPTH; ++layer) {
        { TID_VARS; if (layer == 0 && tid == 0) *(volatile LAS unsigned*)(lds + 131072) = 0u; if (layer == 0 && blk == 0) { unsigned* bw = (unsigned*)(P.ws + opq0() + WS_BAR); for (int i = tid; i < 4096; i += 512) bw[i] = 0u; } phase_prep(P, layer, blk * 512 + tid, G * 512); }
        if (layer == 0) { const int z = opq0(); TID_VARS; phase_norm_x(P.in[I_XP + z], P.in[I_XS + z], MC, 0, WSP(bf16_t, WS_VT), blk * 8 + wave, G * 8, lane); }
        grid.sync();
        { TID_VARS; phase_toeplitz(P, blk * 512 + tid, G * 512); }
        for (int ch = 0; ch < NCHUNK; ++ch) {
            const int row0 = ch * MC;
            { const int z = opq0(); TID_VARS; if (tid < MC / 256) WSP(float, WS_RSS)[blk * (MC / 256) + tid] = 0.f; }
            PH(0) { const int z = opq0(); Gemm g{WSP(bf16_t, WS_VT), WGT(W_IN), 1024, 1024, 1024, 0, 0}; S.init(MC / 256, INP / 256, 1, G, blk, 0);
              EpiIn E{WSP(bf16_t, WS_CQ), WSP(bf16_t, WS_CKV), WSP(bf16_t, WS_KPE), WSP(bf16_t, WS_U2), WSP(bf16_t, WS_ZT), WSP(bf16_t, WS_GATE), WSP(const float2, WS_ROPE)}; pg8::gemm_phase(lds, g, S, E); }
            flat_barrier(P.ws, lds);
            PH(1) { const int z = opq0(); Gemm g{WSP(bf16_t, WS_DFT), WSP(bf16_t, WS_ZT), 4096, 4096, 4096, 0, 0}; S.init(DFTM / 256, CSEQ * FW / 256, 1, G, blk, 0);
              EpiDft E{WSP(bf16_t, WS_PQ)}; pg8::gemm_phase(lds, g, S, E); }
            PH(2) { const int z = opq0(); Gemm g{WSP(bf16_t, WS_U2), WSP(bf16_t, WS_BT1), U2LD, 512, 512, (size_t)512 * U2LD, (size_t)256 * 512}; S.init(2, 1, S5G, G, blk, 108);
              EpiS1 E{WSP(float, WS_S)}; pg8::gemm_phase(lds, g, S, E); }
            if (blk >= 100) {
                const int z = opq0(); TID_VARS;
                if (blk >= 156) { phase_norm_bf(WSP(bf16_t, WS_CQ), 384, (blk - 156) * 8 + wave, 100 * 8, lane); phase_norm_bf(WSP(bf16_t, WS_CKV), 256, (blk - 156) * 8 + wave, 100 * 8, lane); }
                asm volatile("s_waitcnt vmcnt(0)" ::: "memory"); __syncthreads();
                if (tid == 0) {
                    unsigned* fl = (unsigned*)(P.ws + z + WS_BAR) + 192; unsigned sp = 0u;
                    if (blk >= 156) { __builtin_amdgcn_fence(__ATOMIC_RELEASE, "agent"); asm volatile("s_waitcnt vmcnt(0)" ::: "memory"); (void)xb_add(fl, 1u); }
                    const unsigned want = 100u * (unsigned)(layer * NCHUNK + ch + 1);
                    while (xb_ld(fl) < want) { __builtin_amdgcn_s_sleep(2); if (++sp > (1u << 24)) break; }
                    __builtin_amdgcn_fence(__ATOMIC_ACQUIRE, "agent"); asm volatile("s_waitcnt vmcnt(0)" ::: "memory");
                }
                __syncthreads();
            }
            PH(4) { const int z = opq0(); Gemm g{WSP(bf16_t, WS_CQ), WGT(W_QB), 384, 384, 384, 0, 0}; S.init(MC / 256, 6, 1, 148, blk - 108, 0); if (blk < 108) { S.nwg = 0; S.c = 0; }
              EpiQ E{WSP(bf16_t, WS_Q), WSP(const float2, WS_ROPE)}; pg8::gemm_phase(lds, g, S, E); }
            PH(5) { const int z = opq0(); Gemm g{WSP(bf16_t, WS_CKV), WGT(W_KV), 256, 256, 256, 0, 0}; if (blk < 100) { S.init(1, 1, 1, 1, 0, 0); S.nwg = 0; } else if (blk < 108) { S.init(MC / 256, 8, 1, 8, blk - 100, 0); S.nwg = 8; } else { S.init(MC / 256, 8, 1, 148, blk - 108, 88); S.base = 8; }
              EpiKV E{WSP(bf16_t, WS_KN), WSP(bf16_t, WS_VT)}; pg8::gemm_phase(lds, g, S, E); }
            flat_barrier(P.ws, lds);
            { TID_VARS; const int b2 = (blk + 192) % G; phase_s5_scan(P, layer, (b2 < 192 ? b2 * 512 + tid : 1 << 30));
              asm volatile("s_waitcnt vmcnt(0)" ::: "memory"); __syncthreads();
              if (tid == 0 && b2 < 192) { __builtin_amdgcn_fence(__ATOMIC_RELEASE, "agent"); asm volatile("s_waitcnt vmcnt(0)" ::: "memory"); (void)xb_add((unsigned*)(P.ws + opq0() + WS_BAR) + 256, 1u); } }
            PH(3) { const int z = opq0(); Gemm g{WSP(bf16_t, WS_PQ), WGT(W_F), 768, 768, 768, 0, 0}; S.init(MC / 256, 4, 1, G, blk, 0);
              EpiMerge E{WSP(bf16_t, WS_GATE), WSP(bf16_t, WS_MRG), 0, 0}; pg8::gemm_phase(lds, g, S, E); }
            {
                TID_VARS;
                if (tid == 0) { unsigned* fl = (unsigned*)(P.ws + opq0() + WS_BAR) + 256; const unsigned want = 192u * (unsigned)(layer * NCHUNK + ch + 1); unsigned sp = 0u;
                    while (xb_ld(fl) < want) { __builtin_amdgcn_s_sleep(2); if (++sp > (1u << 24)) break; }
                    __builtin_amdgcn_fence(__ATOMIC_ACQUIRE, "agent"); asm volatile("s_waitcnt vmcnt(0)" ::: "memory"); }
                __syncthreads();
            }
            PH(6) { const int z = opq0(); Gemm g{WSP(bf16_t, WS_U2), WSP(bf16_t, WS_BT2), U2LD, 768, 768, (size_t)512 * U2LD, (size_t)512 * 768}; S.init(2, 2, S5G, G, blk, 0);
              EpiS2 E{WSP(bf16_t, WS_U2), P.in[I_SD + z] + layer * 384, WSP(bf16_t, WS_YS5)}; pg8::gemm_phase(lds, g, S, E); }
            {
                TID_VARS; asm volatile("s_waitcnt vmcnt(0)" ::: "memory"); __syncthreads();
                if (tid == 0 && blk < 2 * 2 * S5G) { __builtin_amdgcn_fence(__ATOMIC_RELEASE, "agent"); asm volatile("s_waitcnt vmcnt(0)" ::: "memory"); (void)xb_add((unsigned*)(P.ws + opq0() + WS_BAR) + 128, 1u); }
            }
            PH(7) { const int z = opq0();
              for (int i = 0;; ++i) {
                if (i >= (CSEQ * NH * 8) / 256 || G != 256) { if (G == 256) break; const int uidx0 = i * G + blk; if (uidx0 >= CSEQ * NH * 8) break; }
                const int xcd = blk & 7, slot = blk >> 3;
                const int uidx = G == 256 ? ((i * 32 + xcd * 4 + (slot >> 3)) << 3) + (slot & 7) : i * G + blk;
                const int bh = uidx >> 3, qb = uidx & 7;
                attn_unit(lds, WSP(bf16_t, WS_Q), WSP(bf16_t, WS_KN), WSP(bf16_t, WS_KPE), WSP(bf16_t, WS_VT), WSP(bf16_t, WS_XB), bh >> 4, bh & 15, qb);
              } }
            {
                TID_VARS;
                if (tid == 0) { unsigned* fl = (unsigned*)(P.ws + opq0() + WS_BAR) + 128; const unsigned want = (unsigned)(2 * 2 * S5G) * (unsigned)(layer * NCHUNK + ch + 1); unsigned sp = 0u;
                    while (xb_ld(fl) < want) { __builtin_amdgcn_s_sleep(2); if (++sp > (1u << 24)) break; }
                    __builtin_amdgcn_fence(__ATOMIC_ACQUIRE, "agent"); asm volatile("s_waitcnt vmcnt(0)" ::: "memory"); }
                __syncthreads();
            }
            PH(8) { const int z = opq0(); Gemm g{WSP(bf16_t, WS_YS5), WGT(W_GLU), 384, 384, 384, 0, 0}; S.init(MC / 256, 3, 1, 160, blk - 96, 0); if (blk < 96) { S.nwg = 0; S.c = 0; }
              EpiGlu E{WSP(bf16_t, WS_GLU)}; pg8::gemm_phase(lds, g, S, E); }
            flat_barrier(P.ws, lds);
            PH(9) { const int z = opq0(); Gemm g{WSP(bf16_t, WS_XB), WGT(W_O), 1024, 1024, 1024, 0, 0}; S.init(MC / 256, 4, 1, G, blk, 0);
              EpiMerge E{WSP(bf16_t, WS_GATE), WSP(bf16_t, WS_MRG), 2, 1}; pg8::gemm_phase(lds, g, S, E); }
            PH(10) { const int z = opq0(); Gemm g{WSP(bf16_t, WS_GLU), WGT(W_S5), 384, 384, 384, 0, 0}; S.init(MC / 256, 4, 1, G, blk, 0);
              EpiMerge E{WSP(bf16_t, WS_GATE), WSP(bf16_t, WS_MRG), 1, 1}; pg8::gemm_phase(lds, g, S, E); }
            {
                TID_VARS; pg8::Unit u0; S.init(MC / 256, 4, 1, G, blk, 0); const bool has = S.next(0, u0);
                asm volatile("s_waitcnt vmcnt(0)" ::: "memory"); __syncthreads();
                if (tid == 0 && has) {
                    unsigned* pc = (unsigned*)(P.ws + opq0() + WS_BAR) + 512 + 16 * u0.pm; unsigned sp = 0u;
                    __builtin_amdgcn_fence(__ATOMIC_RELEASE, "agent"); asm volatile("s_waitcnt vmcnt(0)" ::: "memory"); (void)xb_add(pc, 1u);
                    const unsigned want = 4u * (unsigned)(layer * NCHUNK + ch + 1);
                    while (xb_ld(pc) < want) { __builtin_amdgcn_s_sleep(1); if (++sp > (1u << 24)) break; }
                    __builtin_amdgcn_fence(__ATOMIC_ACQUIRE, "agent"); asm volatile("s_waitcnt vmcnt(0)" ::: "memory");
                }
                __syncthreads();
            }
            PH(11) { const int z = opq0(); Gemm g{WSP(bf16_t, WS_MRG), WGT(W_OUT), 1024, 1024, 1024, 0, 0}; S.init(MC / 256, 4, 1, G, blk, 0);
              const float* res = layer == 0 ? (ch == 0 ? P.in[I_XP + z] : P.in[I_XS + z] + (size_t)(row0 - MC) * 1024) : P.out + z + (size_t)row0 * 1024;
              EpiResN E{res, P.out + z + (size_t)row0 * 1024, WSP(bf16_t, WS_XB), WSP(float, WS_RSS)}; pg8::gemm_phase(lds, g, S, E); }
            flat_barrier(P.ws, lds);
            PH(12) { const int z = opq0(); Gemm g{WSP(bf16_t, WS_XB), WGT(W_UP), 1024, 1024, 1024, 0, 0}; S.init(MC / 256, 16, 1, G, blk, 0);
              EpiUpN E{WSP(bf16_t, WS_HID), WSP(const float, WS_RSS)}; pg8::gemm_phase(lds, g, S, E); }
            { const int z = opq0(); TID_VARS; const int nch = ch + 1 < NCHUNK ? ch + 1 : 0, nlayer = ch + 1 < NCHUNK ? layer : layer + 1;
              if (nlayer < DEPTH) {
                if (nlayer == 0) phase_norm_x(P.in[I_XP + z], P.in[I_XS + z], MC, nch * MC, WSP(bf16_t, WS_VT), blk * 8 + wave, G * 8, lane);
                else if (nch != ch || nlayer == layer) phase_norm_x(P.out + z, P.out + z, MTOT, nch * MC, WSP(bf16_t, WS_VT), blk * 8 + wave, G * 8, lane);
              } }
            flat_barrier(P.ws, lds);
            PH(13) { const int z = opq0(); Gemm g{WSP(bf16_t, WS_HID), WGT(W_DOWN), 4096, 4096, 4096, 0, 0}; S.init(MC / 256, 4, 1, G, blk, 0);
              EpiRes E{P.out + z + (size_t)row0 * 1024, P.out + z + (size_t)row0 * 1024}; pg8::gemm_phase(lds, g, S, E); }
            if (ch == NCHUNK - 1) flat_barrier(P.ws, lds);
        }
    }
    {
        const int z = opq0(); TID_VARS; const float* gf = P.in[I_GFIN + z];
        for (int r = blk * 8 + wave; r < MTOT; r += G * 8) {
            float* row = P.out + z + (size_t)r * 1024; f32x4 v[4]; float ss = 0.f;
#pragma unroll
            for (int j = 0; j < 4; ++j) { v[j] = *(const f32x4*)(row + j * 256 + lane * 4); ss += v[j][0] * v[j][0] + v[j][1] * v[j][1] + v[j][2] * v[j][2] + v[j][3] * v[j][3]; }
            ss = wave_sum(ss); const float rs = rsqrtf(ldexpf(ss + 1024.0f * EPS, -10));
#pragma unroll
            for (int j = 0; j < 4; ++j) { const f32x4 gg = *(const f32x4*)(gf + j * 256 + lane * 4); *(f32x4*)(row + j * 256 + lane * 4) = v[j] * rs * gg; }
        }
    }
#undef WSP
#undef WGT
}

extern "C" void kernel_launch(void* const* d_in, const int* in_sizes, int n_in, void* d_out, int out_size, void* d_ws, size_t ws_size, hipStream_t stream) {
    static int grid = 0;
    if (grid == 0) {
        if (n_in != 25 || out_size != MTOT * D || ws_size < WS_END) { fprintf(stderr, "kernel_launch: unexpected shapes (n_in %d out %d ws %zu)\n", n_in, out_size, ws_size); grid = -1; return; }
        int dev = 0, cus = 0, per_cu = 0;
        if (hipGetDevice(&dev) != hipSuccess || hipDeviceGetAttribute(&cus, hipDeviceAttributeMultiprocessorCount, dev) != hipSuccess) { grid = -1; return; }
        if (hipFuncSetAttribute((const void*)mega, hipFuncAttributeMaxDynamicSharedMemorySize, LDS_BYTES) != hipSuccess) { fprintf(stderr, "kernel_launch: hipFuncSetAttribute failed\n"); grid = -1; return; }
        if (hipOccupancyMaxActiveBlocksPerMultiprocessor(&per_cu, (const void*)mega, 512, LDS_BYTES) != hipSuccess || per_cu < 1) { fprintf(stderr, "kernel_launch: occupancy query says %d\n", per_cu); per_cu = 1; }
        (void)hipGetLastError();
        grid = cus * 1;
    }
    if (grid < 0) return;
    Params p{};
    for (int i = 0; i < 25; ++i) p.in[i] = (const float*)d_in[i];
    p.out = (float*)d_out; p.ws = (unsigned char*)d_ws;
    void* args[] = {&p};
    hipError_t e = hipLaunchCooperativeKernel((const void*)mega, dim3(grid), dim3(512), args, LDS_BYTES, stream);
    if (e != hipSuccess) fprintf(stderr, "cooperative launch failed: %s (grid %d)\n", hipGetErrorString(e), grid);
}
```
